# Optimizing an MI355X kernel written in HIP

```python
import jax, jax.numpy as jnp
from jax import lax
import numpy as np

D_MODEL = 2048
BATCH = 4
SEQ = 4096
DEPTH = 1
DEC_BATCH = 8
DEC_SEQ = 64
PAST_LEN = 2048

CHUNK = 64
N_PAST_CHUNKS = 8
BAND_PAST = N_PAST_CHUNKS * CHUNK
BAND_LEN = BAND_PAST + CHUNK
BAND_HEADS = 8
BAND_HEAD_DIM = 128
BAND_WIDTH = BAND_HEADS * BAND_HEAD_DIM
REL_MAX = 256
REL_SIZE = (CHUNK - 1) + REL_MAX + 1
BAND_SCALE = BAND_HEAD_DIM ** -0.5
MLA_HEADS = 8
MLA_NOPE = 128
MLA_ROPE = 64
MLA_QK = MLA_NOPE + MLA_ROPE
MLA_V = 128
MLA_WIDTH = MLA_HEADS * MLA_V
MLA_KV_RANK = 512
MLA_SCALE = MLA_QK ** -0.5
ROPE_THETA = 10000.0
D_FF = 4 * D_MODEL
Q_BLOCK = 128
EPS = 1e-6
_IN_WIDTHS = (BAND_WIDTH, BAND_WIDTH, BAND_WIDTH, MLA_HEADS * MLA_QK, MLA_KV_RANK, MLA_ROPE, D_MODEL, D_MODEL)
D_IN_PROJ = sum(_IN_WIDTHS)
SPLIT_POINTS = tuple(sum(_IN_WIDTHS[:i + 1]) for i in range(len(_IN_WIDTHS) - 1))

kernel_name = 'streaming_band_mla_hybrid_step'


def rms_norm(x, g):
    xf = x.astype(jnp.float32)
    y = xf * lax.rsqrt(jnp.mean(xf * xf, axis=-1, keepdims=True) + EPS)
    return (y * g.astype(jnp.float32)).astype(x.dtype)


def rope(x, pos):
    half = x.shape[-1] // 2
    freqs = ROPE_THETA ** (-(jnp.arange(half, dtype=jnp.float32) / half))
    ang = pos.astype(jnp.float32)[:, None] * freqs[None, :]
    shape = (1, x.shape[1]) + (1,) * (x.ndim - 3) + (half,)
    cos = jnp.cos(ang).reshape(shape)
    sin = jnp.sin(ang).reshape(shape)
    xf = x.astype(jnp.float32)
    x1, x2 = xf[..., :half], xf[..., half:]
    return jnp.concatenate([x1 * cos - x2 * sin, x2 * cos + x1 * sin], axis=-1).astype(x.dtype)


def band_bias(n_q, n_past, n_k, table):
    dist = n_past + jnp.arange(n_q)[:, None] - jnp.arange(n_k)[None, :]
    idx = jnp.clip(dist, -(CHUNK - 1), REL_MAX) + (CHUNK - 1)
    return table[:, idx].astype(jnp.float32)


def mixer_projections(x, pos, norm_g, w_in, g_aq, g_ak, g_kv, g_kr, g_qn, g_qr):
    b, s = x.shape[0], x.shape[1]
    xn = rms_norm(x, norm_g)
    h = xn @ w_in
    aq, ak, av, bq, ckv, kr, ga, gb = jnp.split(h, SPLIT_POINTS, axis=-1)
    aq = rms_norm(aq.reshape(b, s, BAND_HEADS, BAND_HEAD_DIM), g_aq)
    ak = rms_norm(ak.reshape(b, s, BAND_HEADS, BAND_HEAD_DIM), g_ak)
    av = av.reshape(b, s, BAND_HEADS, BAND_HEAD_DIM)
    bq = bq.reshape(b, s, MLA_HEADS, MLA_QK)
    qn = rms_norm(bq[..., :MLA_NOPE], g_qn)
    qr = rope(rms_norm(bq[..., MLA_NOPE:], g_qr), pos)
    ckv = rms_norm(ckv, g_kv)
    kr = rope(rms_norm(kr, g_kr), pos)
    return aq, ak, av, qn, qr, ckv, kr, ga, gb


def band_attention_prompt(q, k, v, table):
    b, s = q.shape[0], q.shape[1]
    nc = s // CHUNK
    pad = jnp.zeros((b, BAND_PAST, BAND_HEADS, BAND_HEAD_DIM), k.dtype)
    kp = jnp.concatenate([pad, k], axis=1)
    vp = jnp.concatenate([pad, v], axis=1)
    valid = jnp.arange(BAND_PAST + s) >= BAND_PAST
    bias = band_bias(CHUNK, BAND_PAST, BAND_LEN, table)
    qc = q.reshape(b, nc, CHUNK, BAND_HEADS, BAND_HEAD_DIM).swapaxes(0, 1)

    def step(args):
        c, qb = args
        start = c * CHUNK
        kb = lax.dynamic_slice_in_dim(kp, start, BAND_LEN, axis=1)
        vb = lax.dynamic_slice_in_dim(vp, start, BAND_LEN, axis=1)
        mb = lax.dynamic_slice_in_dim(valid, start, BAND_LEN, axis=0)
        sc = jnp.einsum('bqhd,bkhd->bhqk', qb, kb).astype(jnp.float32) * BAND_SCALE + bias[None]
        sc = jnp.where(mb[None, None, None, :], sc, -jnp.inf)
        p = jax.nn.softmax(sc, axis=-1).astype(vb.dtype)
        return jnp.einsum('bhqk,bkhd->bqhd', p, vb)

    out = lax.map(step, (jnp.arange(nc), qc))
    return out.swapaxes(0, 1).reshape(b, s, BAND_WIDTH)


def band_attention_sample(q, k_new, v_new, k_cache, v_cache, table):
    b, t = q.shape[0], q.shape[1]
    n_past = k_cache.shape[1]
    kb = jnp.concatenate([k_cache.astype(k_new.dtype), k_new], axis=1)
    vb = jnp.concatenate([v_cache.astype(v_new.dtype), v_new], axis=1)
    bias = band_bias(t, n_past, n_past + t, table)
    sc = jnp.einsum('bqhd,bkhd->bhqk', q, kb).astype(jnp.float32) * BAND_SCALE + bias[None]
    p = jax.nn.softmax(sc, axis=-1).astype(vb.dtype)
    return jnp.einsum('bhqk,bkhd->bqhd', p, vb).reshape(b, t, BAND_WIDTH)


def mla_expand(ckv, w_kv_b, g_kn):
    b, l = ckv.shape[0], ckv.shape[1]
    kv = (ckv @ w_kv_b).reshape(b, l, MLA_HEADS, MLA_NOPE + MLA_V)
    kn = rms_norm(kv[..., :MLA_NOPE], g_kn)
    return kn, kv[..., MLA_NOPE:]


def mla_block(qn, qr, qpos, kn, kr, v, kpos):
    sc = (jnp.einsum('bqhd,bkhd->bhqk', qn, kn) + jnp.einsum('bqhr,bkr->bhqk', qr, kr)).astype(jnp.float32) * MLA_SCALE
    mask = (kpos[None, :] // CHUNK) <= (qpos[:, None] // CHUNK)
    sc = jnp.where(mask[None, None], sc, -jnp.inf)
    p = jax.nn.softmax(sc, axis=-1).astype(v.dtype)
    return jnp.einsum('bhqk,bkhd->bqhd', p, v)


def mla_attention_prompt(qn, qr, kn, kr, v, pos):
    b, s = qn.shape[0], qn.shape[1]
    nb = s // Q_BLOCK

    def to_blocks(t):
        return t.reshape((b, nb, Q_BLOCK) + t.shape[2:]).swapaxes(0, 1)

    out = lax.map(lambda a: mla_block(a[0], a[1], a[2], kn, kr, v, pos),
                  (to_blocks(qn), to_blocks(qr), pos.reshape(nb, Q_BLOCK)))
    return out.swapaxes(0, 1).reshape(b, s, MLA_WIDTH)


def merge_and_ffn(x, oa, ob, ga, gb, w_pa, w_pb, w_out, norm_ffn_g, w_up, w_down):
    mix = jax.nn.sigmoid(ga) * (oa @ w_pa) + jax.nn.sigmoid(gb) * (ob @ w_pb)
    h = x + mix @ w_out
    u = jnp.square(jax.nn.relu(rms_norm(h, norm_ffn_g) @ w_up))
    return h + u @ w_down


def setup_inputs(seed: int = 0) -> dict:
    key = jax.random.key(seed)
    ks = jax.random.split(key, 24)
    f32 = jnp.float32

    def nrm(k, shape, scale):
        return jax.random.normal(k, shape, f32) * scale

    def gain(k, n):
        return 1.0 + 0.01 * jax.random.normal(k, (DEPTH, n), f32)

    a_cache_len = min(BAND_PAST, PAST_LEN)
    return {
        'x_prompt': nrm(ks[0], (BATCH, SEQ, D_MODEL), 1.0),
        'x_sample': nrm(ks[1], (DEC_BATCH, DEC_SEQ, D_MODEL), 1.0),
        'cache_a_k': nrm(ks[2], (DEPTH, DEC_BATCH, a_cache_len, BAND_HEADS, BAND_HEAD_DIM), 1.0),
        'cache_a_v': nrm(ks[3], (DEPTH, DEC_BATCH, a_cache_len, BAND_HEADS, BAND_HEAD_DIM), 1.0),
        'cache_mla_ckv': nrm(ks[4], (DEPTH, DEC_BATCH, PAST_LEN, MLA_KV_RANK), 1.0),
        'cache_mla_krope': nrm(ks[5], (DEPTH, DEC_BATCH, PAST_LEN, MLA_ROPE), 1.0),
        'norm_mix_g': gain(ks[6], D_MODEL),
        'w_in': nrm(ks[7], (DEPTH, D_MODEL, D_IN_PROJ), D_MODEL ** -0.5),
        'g_aq': gain(ks[8], BAND_HEAD_DIM),
        'g_ak': gain(ks[9], BAND_HEAD_DIM),
        'rel_bias': nrm(ks[10], (DEPTH, BAND_HEADS, REL_SIZE), 0.5),
        'g_kv': gain(ks[11], MLA_KV_RANK),
        'g_kr': gain(ks[12], MLA_ROPE),
        'g_qn': gain(ks[13], MLA_NOPE),
        'g_qr': gain(ks[14], MLA_ROPE),
        'g_kn': gain(ks[15], MLA_NOPE),
        'w_kv_b': nrm(ks[16], (DEPTH, MLA_KV_RANK, MLA_HEADS * (MLA_NOPE + MLA_V)), MLA_KV_RANK ** -0.5),
        'w_pa': nrm(ks[17], (DEPTH, BAND_WIDTH, D_MODEL), BAND_WIDTH ** -0.5),
        'w_pb': nrm(ks[18], (DEPTH, MLA_WIDTH, D_MODEL), MLA_WIDTH ** -0.5),
        'w_out': nrm(ks[19], (DEPTH, D_MODEL, D_MODEL), D_MODEL ** -0.5),
        'norm_ffn_g': gain(ks[20], D_MODEL),
        'w_up': nrm(ks[21], (DEPTH, D_MODEL, D_FF), D_MODEL ** -0.5),
        'w_down': nrm(ks[22], (DEPTH, D_FF, D_MODEL), D_FF ** -0.5),
    }


def reference(x_prompt, x_sample, cache_a_k, cache_a_v, cache_mla_ckv, cache_mla_krope,
              norm_mix_g, w_in, g_aq, g_ak, rel_bias, g_kv, g_kr, g_qn, g_qr, g_kn,
              w_kv_b, w_pa, w_pb, w_out, norm_ffn_g, w_up, w_down):
    s = x_prompt.shape[1]
    t = x_sample.shape[1]
    past = cache_mla_ckv.shape[2]
    keep = min(BAND_PAST, s)
    pos_p = jnp.arange(s)
    pos_s = past + jnp.arange(t)
    kpos_s = jnp.arange(past + t)
    yp, ys = x_prompt, x_sample
    akp, avp, ckp, krp, aks, avs, cks, krs = [], [], [], [], [], [], [], []
    for l in range(DEPTH):
        aq, ak, av, qn, qr, ckv, kr, ga, gb = mixer_projections(
            yp, pos_p, norm_mix_g[l], w_in[l], g_aq[l], g_ak[l], g_kv[l], g_kr[l], g_qn[l], g_qr[l])
        oa = band_attention_prompt(aq, ak, av, rel_bias[l])
        kn, vb = mla_expand(ckv, w_kv_b[l], g_kn[l])
        ob = mla_attention_prompt(qn, qr, kn, kr, vb, pos_p)
        akp.append(ak[:, s - keep:])
        avp.append(av[:, s - keep:])
        ckp.append(ckv)
        krp.append(kr)
        yp = merge_and_ffn(yp, oa, ob, ga, gb, w_pa[l], w_pb[l], w_out[l], norm_ffn_g[l], w_up[l], w_down[l])
        aq, ak, av, qn, qr, ckv, kr, ga, gb = mixer_projections(
            ys, pos_s, norm_mix_g[l], w_in[l], g_aq[l], g_ak[l], g_kv[l], g_kr[l], g_qn[l], g_qr[l])
        oa = band_attention_sample(aq, ak, av, cache_a_k[l], cache_a_v[l], rel_bias[l])
        ckv_all = jnp.concatenate([cache_mla_ckv[l].astype(ckv.dtype), ckv], axis=1)
        kr_all = jnp.concatenate([cache_mla_krope[l].astype(kr.dtype), kr], axis=1)
        kn, vb = mla_expand(ckv_all, w_kv_b[l], g_kn[l])
        ob = mla_block(qn, qr, pos_s, kn, kr_all, vb, kpos_s).reshape(ys.shape[0], t, MLA_WIDTH)
        aks.append(ak)
        avs.append(av)
        cks.append(ckv)
        krs.append(kr)
        ys = merge_and_ffn(ys, oa, ob, ga, gb, w_pa[l], w_pb[l], w_out[l], norm_ffn_g[l], w_up[l], w_down[l])
    return (yp, ys, jnp.stack(akp), jnp.stack(avp), jnp.stack(ckp), jnp.stack(krp),
            jnp.stack(aks), jnp.stack(avs), jnp.stack(cks), jnp.stack(krs))
```

```cpp
#include <hip/hip_runtime.h>
#include <hip/hip_cooperative_groups.h>
#include <cstdio>
#include <cstdint>
namespace cg = cooperative_groups;
namespace pg8 {
#define PG8_LAS __attribute__((address_space(3)))
typedef unsigned short bf16_t;
typedef short bf16x8 __attribute__((ext_vector_type(8)));
typedef float f32x4 __attribute__((ext_vector_type(4)));
typedef unsigned u32x4 __attribute__((ext_vector_type(4)));
constexpr int BM = 256, BK = 64, HALF = 128, HTB = HALF * BK * 2  , STAGE_BYTES = 8 * HTB, NXCD = 8, WGM = 8;

__host__ __device__ __forceinline__ int lds_byte(int r, int c) { const int st = (r >> 4) * 2 + (c >> 5), rr = r & 15, cc = c & 31, ob = rr * 64 + cc * 2; return st * 1024 + (ob ^ (((ob >> 9) & 1) << 5)); }
__host__ __device__ __forceinline__ void stage_rc(int b, int& R, int& C) { const int st = b / 1024, sb = b % 1024, swz = sb ^ (((sb >> 9) & 1) << 5); R = (st >> 1) * 16 + swz / 64; C = (st & 1) * 32 + (swz % 64) / 2; }
__host__ __device__ __forceinline__ int perm32(int rho) { const int n = rho >> 4, i = rho & 15; return 8 * (i >> 2) + 4 * n + (i & 3); }

struct Unit { int pm, pn, ks; };
struct Gemm { const bf16_t* A; const bf16_t* Bt; int M, N, K, lda, ldb; };

struct StaticOrder {
    int nM, nN, nwg, G, c;
    __host__ __device__ void init(int M, int N, int G_, int c_) { nM = M / BM; nN = N / BM; nwg = nM * nN; G = G_; c = c_; }
    __host__ __device__ bool next(int i, Unit& u) const {
        const long L = (long)i * G + c; if (L >= nwg) return false;
        int wgid = (int)L; { const int q = nwg / NXCD, r = nwg % NXCD, xcd = wgid % NXCD, off = wgid / NXCD; wgid = (xcd < r ? xcd * (q + 1) : r * (q + 1) + (xcd - r) * q) + off; }
        const int nig = WGM * nN, gid = wgid / nig, fm = gid * WGM, gsz = (nM - fm) < WGM ? (nM - fm) : WGM;
        u.pm = fm + ((wgid % nig) % gsz); u.pn = (wgid % nig) / gsz; u.ks = 0; return true;
    }
    __device__ __forceinline__ void a_ready(const Unit&) const {}
    __device__ __forceinline__ void done(const Unit&) const {}
};

struct SplitOrder {
    int nM, nN, S, G, c;
    __host__ __device__ void init(int M, int N, int S_, int G_, int c_) { nM = M / BM; nN = N / BM; S = S_; G = G_; c = c_; }
    __host__ __device__ bool next(int i, Unit& u) const {
        const long L = (long)i * G + c; if (L >= (long)nM * nN * S) return false;
        u.ks = (int)(L % S); const int t = (int)(L / S); u.pn = t % nN; u.pm = t / nN; return true;
    }
    __device__ __forceinline__ void a_ready(const Unit&) const {}
    __device__ __forceinline__ void done(const Unit&) const {}
};
__device__ __forceinline__ unsigned cvt_pk_bf16(float lo, float hi) { unsigned r; asm volatile("v_cvt_pk_bf16_f32 %0, %1, %2" : "=v"(r) : "v"(lo), "v"(hi)); return r; }
template <class Epi, class Sched, bool ALIGN_EPI = false, bool SP2 = false>
__device__ __forceinline__ void gemm_phase(PG8_LAS unsigned char* lds, const Gemm g, const Sched& S, const Epi& E) {
    const int tid = threadIdx.x, wid = __builtin_amdgcn_readfirstlane(tid >> 6), lane = tid & 63, wr = wid >> 2, wc = wid & 3, fr = lane & 15, fq = lane >> 4;
    const int K = g.K, nt = K / BK;
    unsigned voffA[2], voffB[2];
#pragma unroll
    for (int i = 0; i < 2; ++i) { int R, C; stage_rc(tid * 16 + i * 8192, R, C); const int Rb = Epi::PERM ? ((R & ~31) + perm32(R & 31)) : R;
        voffA[i] = (unsigned)(R * g.lda + C) * 2u; voffB[i] = (unsigned)(Rb * g.ldb + C) * 2u; }
    const size_t kstep = (size_t)(BK * 2);
    const size_t hstepA = (size_t)HALF * g.lda * 2, hstepB = (size_t)HALF * g.ldb * 2;
    const size_t tstepA = 2 * hstepA, tstepB = 2 * hstepB, sstep = (size_t)K * 2;
    const unsigned ldsw = (unsigned)wid * 1024u;
    const int aoff = lds_byte(wr * 64 + fr, fq * 8), boff = lds_byte(wc * 32 + fr, fq * 8);
#define PG8_SA(b, h) (((b) * 2 + (h)) * HTB)
#define PG8_SB(b, h) ((4 + (b) * 2 + (h)) * HTB)
#define PG8_STAGE(bufoff, gbase, voff) do { _Pragma("unroll") for (int _i = 0; _i < 2; ++_i) \
        __builtin_amdgcn_global_load_lds((const unsigned*)((const char*)(gbase) + (voff)[_i]), (PG8_LAS unsigned*)(lds + (bufoff) + ldsw + _i * 8192), 16, 0, 0); } while (0)
#define PG8_LDA(dst, b, h) do { _Pragma("unroll") for (int m = 0; m < 4; ++m) _Pragma("unroll") for (int k = 0; k < 2; ++k) dst[m][k] = *(const PG8_LAS bf16x8*)(lds + PG8_SA(b, h) + aoff + m * 2048 + k * 1024); } while (0)
#define PG8_LDB(dst, b, h) do { _Pragma("unroll") for (int n = 0; n < 2; ++n) _Pragma("unroll") for (int k = 0; k < 2; ++k) dst[n][k] = *(const PG8_LAS bf16x8*)(lds + PG8_SB(b, h) + boff + n * 2048 + k * 1024); } while (0)
#define PG8_MMA(ai, bj, At, Bt) do { __builtin_amdgcn_s_setprio(1); _Pragma("unroll") for (int m = 0; m < 4; ++m) _Pragma("unroll") for (int n = 0; n < 2; ++n) _Pragma("unroll") for (int k = 0; k < 2; ++k) \
        acc[ai][bj][m][n] = __builtin_amdgcn_mfma_f32_16x16x32_bf16(Bt[n][k], At[m][k], acc[ai][bj][m][n], 0, 0, 0); __builtin_amdgcn_s_setprio(0); } while (0)
#define PG8_WAIT_V(n) asm volatile("s_waitcnt vmcnt(" #n ")" ::: "memory")
#define PG8_WAIT_L(n) asm volatile("s_waitcnt lgkmcnt(" #n ")" ::: "memory")
#define PG8_BAR __builtin_amdgcn_s_barrier()
#define PG8_SCHED __builtin_amdgcn_sched_barrier(0)
    Unit cur, nxt; int ui = 0;
    if (!S.next(0, cur)) return;
    f32x4 acc[2][2][4][2];
#pragma unroll
    for (int a = 0; a < 2; ++a)
#pragma unroll
        for (int b = 0; b < 2; ++b)
#pragma unroll
            for (int m = 0; m < 4; ++m)
#pragma unroll
                for (int n = 0; n < 2; ++n) acc[a][b][m][n] = (f32x4){0.f, 0.f, 0.f, 0.f};
    bf16x8 At[4][2], B0[2][2], B1[2][2];
    const char* cA = (const char*)g.A + (size_t)cur.pm * tstepA + (size_t)cur.ks * sstep; const char* cB = (const char*)g.Bt + (size_t)cur.pn * tstepB + (size_t)cur.ks * sstep;
    S.a_ready(cur);
    if constexpr (SP2) {
        PG8_STAGE(PG8_SB(0, 0), cB, voffB); PG8_STAGE(PG8_SB(0, 1), cB + hstepB, voffB); PG8_STAGE(PG8_SA(0, 0), cA, voffA); PG8_STAGE(PG8_SA(0, 1), cA + hstepA, voffA);
        if (wr == 1) PG8_BAR;
        PG8_WAIT_V(2); PG8_BAR;
        PG8_STAGE(PG8_SB(1, 0), cB + kstep, voffB); PG8_STAGE(PG8_SA(1, 0), cA + kstep, voffA); PG8_STAGE(PG8_SB(1, 1), cB + hstepB + kstep, voffB);
        PG8_WAIT_V(6); PG8_BAR;
    } else {
        PG8_STAGE(PG8_SB(0, 0), cB, voffB); PG8_STAGE(PG8_SA(0, 0), cA, voffA); PG8_STAGE(PG8_SB(0, 1), cB + hstepB, voffB); PG8_STAGE(PG8_SA(0, 1), cA + hstepA, voffA);
        if (wr == 1) PG8_BAR;
        PG8_WAIT_V(4); PG8_BAR;
        PG8_STAGE(PG8_SB(1, 0), cB + kstep, voffB); PG8_STAGE(PG8_SA(1, 0), cA + kstep, voffA); PG8_STAGE(PG8_SB(1, 1), cB + hstepB + kstep, voffB);
        PG8_WAIT_V(6); PG8_BAR;
    }
    for (;;) {
        const bool has_next = S.next(ui + 1, nxt);
        const char* nA = has_next ? (const char*)g.A + (size_t)nxt.pm * tstepA + (size_t)nxt.ks * sstep : cA; const char* nB = has_next ? (const char*)g.Bt + (size_t)nxt.pn * tstepB + (size_t)nxt.ks * sstep : cB;
        for (int t = 0; t < nt; t += 2) {
            const bool last = (t == nt - 2);
            const char* a1 = cA + (size_t)(t + 1) * kstep;
            const char* a2 = last ? nA : cA + (size_t)(t + 2) * kstep; const char* b2 = last ? nB : cB + (size_t)(t + 2) * kstep;
            const char* a3 = a2 + kstep; const char* b3 = b2 + kstep;
            if (last && has_next) S.a_ready(nxt);
            if constexpr (SP2) {
            PG8_LDB(B0, 0, 0); PG8_LDB(B1, 0, 1); PG8_SCHED; PG8_LDA(At, 0, 0); PG8_STAGE(PG8_SA(1, 1), a1 + hstepA, voffA);
            PG8_WAIT_V(8); PG8_WAIT_L(0); PG8_BAR; PG8_MMA(0, 0, At, B0); PG8_MMA(0, 1, At, B1); PG8_BAR; PG8_SCHED;
            PG8_LDA(At, 0, 1); PG8_STAGE(PG8_SB(0, 0), b2, voffB); PG8_STAGE(PG8_SB(0, 1), b2 + hstepB, voffB); PG8_STAGE(PG8_SA(0, 0), a2, voffA);
            PG8_WAIT_V(8); PG8_WAIT_L(0); PG8_BAR; PG8_MMA(1, 0, At, B0); PG8_MMA(1, 1, At, B1); PG8_BAR; PG8_SCHED;
            PG8_LDB(B0, 1, 0); PG8_LDB(B1, 1, 1); PG8_SCHED; PG8_LDA(At, 1, 0); PG8_STAGE(PG8_SA(0, 1), a2 + hstepA, voffA);
            PG8_WAIT_V(8); PG8_WAIT_L(0); PG8_BAR; PG8_MMA(0, 0, At, B0); PG8_MMA(0, 1, At, B1); PG8_BAR; PG8_SCHED;
            PG8_LDA(At, 1, 1); PG8_STAGE(PG8_SB(1, 0), b3, voffB); PG8_STAGE(PG8_SB(1, 1), b3 + hstepB, voffB); PG8_STAGE(PG8_SA(1, 0), a3, voffA);
            PG8_WAIT_V(8); PG8_WAIT_L(0); PG8_BAR; PG8_MMA(1, 0, At, B0); PG8_MMA(1, 1, At, B1); PG8_BAR; PG8_SCHED;
            } else {
            PG8_LDB(B0, 0, 0); PG8_SCHED; PG8_LDA(At, 0, 0); PG8_STAGE(PG8_SA(1, 1), a1 + hstepA, voffA);
            PG8_WAIT_L(8); PG8_BAR; PG8_WAIT_L(0); PG8_MMA(0, 0, At, B0); PG8_BAR; PG8_SCHED;
            PG8_LDB(B1, 0, 1); PG8_STAGE(PG8_SB(0, 0), b2, voffB);
            PG8_BAR; PG8_WAIT_L(0); PG8_MMA(0, 1, At, B1); PG8_BAR;
            PG8_LDA(At, 0, 1); PG8_STAGE(PG8_SA(0, 0), a2, voffA);
            PG8_BAR; PG8_WAIT_L(0); PG8_MMA(1, 0, At, B0); PG8_BAR; PG8_SCHED;
            PG8_STAGE(PG8_SB(0, 1), b2 + hstepB, voffB);
            PG8_WAIT_V(6); PG8_BAR; PG8_MMA(1, 1, At, B1); PG8_BAR;
            PG8_LDB(B0, 1, 0); PG8_SCHED; PG8_LDA(At, 1, 0); PG8_STAGE(PG8_SA(0, 1), a2 + hstepA, voffA);
            PG8_WAIT_L(8); PG8_BAR; PG8_WAIT_L(0); PG8_MMA(0, 0, At, B0); PG8_BAR; PG8_SCHED;
            PG8_LDB(B1, 1, 1); PG8_STAGE(PG8_SB(1, 0), b3, voffB);
            PG8_BAR; PG8_WAIT_L(0); PG8_MMA(0, 1, At, B1); PG8_BAR;
            PG8_LDA(At, 1, 1); PG8_STAGE(PG8_SA(1, 0), a3, voffA);
            PG8_BAR; PG8_WAIT_L(0); PG8_MMA(1, 0, At, B0); PG8_BAR; PG8_SCHED;
            PG8_STAGE(PG8_SB(1, 1), b3 + hstepB, voffB);
            PG8_WAIT_V(6); PG8_BAR; PG8_MMA(1, 1, At, B1); PG8_BAR;
            }
        }
        if constexpr (ALIGN_EPI) { if (wr == 0) PG8_BAR; }
        if constexpr (!Epi::AFTER_DRAIN) { E(acc, cur, wr, wc, fr, fq); S.done(cur); }
        if (!has_next) break;
#pragma unroll
        for (int a = 0; a < 2; ++a)
#pragma unroll
            for (int b = 0; b < 2; ++b)
#pragma unroll
                for (int m = 0; m < 4; ++m)
#pragma unroll
                    for (int n = 0; n < 2; ++n) acc[a][b][m][n] = (f32x4){0.f, 0.f, 0.f, 0.f};
        cur = nxt; cA = nA; cB = nB; ++ui;
        if constexpr (ALIGN_EPI) { if (wr == 1) PG8_BAR; }
    }
    PG8_WAIT_V(0);
    if constexpr (!ALIGN_EPI) { if (wr == 0) PG8_BAR; }
    PG8_BAR;
    if constexpr (Epi::AFTER_DRAIN) { E.fused(acc, cur, wr, wc, fr, fq, lds, wid, lane); S.done(cur); }
#undef PG8_SA
#undef PG8_SB
#undef PG8_STAGE
#undef PG8_LDA
#undef PG8_LDB
#undef PG8_MMA
#undef PG8_WAIT_V
#undef PG8_WAIT_L
#undef PG8_BAR
#undef PG8_SCHED
}
}

#define DI __device__ __forceinline__
#define LAS __attribute__((address_space(3)))
typedef unsigned short bf16;
typedef short bf16x8 __attribute__((ext_vector_type(8)));
typedef short s16x4 __attribute__((ext_vector_type(4)));
typedef short v4i16_t __attribute__((ext_vector_type(4)));
typedef float f32x16 __attribute__((ext_vector_type(16)));
typedef float f32x4 __attribute__((ext_vector_type(4)));
typedef unsigned u32x4 __attribute__((ext_vector_type(4)));
typedef unsigned u32x2 __attribute__((ext_vector_type(2)));
typedef float f32x2_t __attribute__((ext_vector_type(2)));
typedef __bf16 bf16x2_t __attribute__((ext_vector_type(2)));

constexpr int DM = 2048, MP = 16384, MS = 512, MT = 16896, NIN = 9472, DFF = 8192, RALL = 33280;
constexpr size_t MiB = 1048576;
constexpr size_t WS_WKVB = 1 * MiB, WS_WPA = 3 * MiB, WS_WPB = 7 * MiB, WS_WOUT = 11 * MiB, WS_WIN = 19 * MiB, WS_OB = 19 * MiB,
                 WS_XN = 56 * MiB, WS_KN = 56 * MiB, WS_MIX = 56 * MiB, WS_AQ = 122 * MiB, WS_AK = 155 * MiB, WS_AV = 188 * MiB, WS_VB = 155 * MiB,
                 WS_BQ = 221 * MiB, WS_CKV = 271 * MiB, WS_KR = 304 * MiB, WS_GA = 309 * MiB, WS_GB = 375 * MiB, WS_AKS = 441 * MiB, WS_AVS = 450 * MiB,
                 WS_OA = 122 * MiB, WS_VTMP = 460 * MiB, WS_PART1 = 221 * MiB, WS_PART2 = 1 * MiB, WS_H16 = 331 * MiB, WS_WUP = 448 * MiB, WS_WDN = 480 * MiB, WS_HN = 1 * MiB, WS_U = 67 * MiB, WS_END = 512 * MiB;
constexpr size_t AQ_ELEMS = (size_t)MT * 1024, GA_ELEMS = (size_t)MT * 2048;
constexpr size_t O_YP = 0, O_YS = 33554432, O_AKP = 34603008, O_AVP = 36700160, O_CKP = 38797312, O_KRP = 47185920,
                 O_AKS = 48234496, O_AVS = 48758784, O_CKS = 49283072, O_KRS = 49545216;
constexpr int LDS_BYTES = 143360;
constexpr float EPS = 1e-6f;
constexpr float LOG2E = 1.4426950408889634f;
constexpr float QS_BAND = 0.08838834764831845f * 1.4426950408889634f;
constexpr float QS_MLA = 0.07216878364870322f * 1.4426950408889634f;

DI unsigned pk2(float lo, float hi) { f32x2_t v = {lo, hi}; bf16x2_t b = __builtin_convertvector(v, bf16x2_t); return __builtin_bit_cast(unsigned, b); }
DI float bflo(unsigned w) { return __builtin_bit_cast(float, w << 16); }
DI float bfhi(unsigned w) { return __builtin_bit_cast(float, w & 0xffff0000u); }
DI float bf1(bf16 v) { return __builtin_bit_cast(float, ((unsigned)v) << 16); }
DI bf16 tobf(float f) { return (bf16)(pk2(f, 0.f) & 0xffffu); }
DI float wave_sum(float v) {
#pragma unroll
    for (int o = 32; o >= 1; o >>= 1) v += __shfl_xor(v, o);
    return v;
}
DI void unpack8(u32x4 w, float* f) { f[0] = bflo(w.x); f[1] = bfhi(w.x); f[2] = bflo(w.y); f[3] = bfhi(w.y); f[4] = bflo(w.z); f[5] = bfhi(w.z); f[6] = bflo(w.w); f[7] = bfhi(w.w); }
DI u32x4 pack8(const float* f) { u32x4 w; w.x = pk2(f[0], f[1]); w.y = pk2(f[2], f[3]); w.z = pk2(f[4], f[5]); w.w = pk2(f[6], f[7]); return w; }
DI float sigmoidf_(float x) { return __builtin_amdgcn_rcpf(1.0f + __builtin_amdgcn_exp2f(-x * LOG2E)); }

struct Args { const float* in[23]; float* out; unsigned char* ws; int ph_lo, ph_hi, rep, pad; };

using pg8::Unit;
typedef const pg8::f32x4 (&AccRef)[2][2][4][2];

DI int rmap_row(int row) { return row < MP ? row : MP + ((row - MP) >> 6) * 2112 + 2048 + ((row - MP) & 63); }

struct EpiInProj {
    static constexpr bool PERM = true, AFTER_DRAIN = false;
    bf16 *AQ, *BQ, *CKV, *KR, *GA; bf16 *AKS, *AVS; float* out; const float* gtab; LAS float* xch;
    DI void cache_out(const float* r, const Unit& u, int row, int col, bool isv) const {
        if (u.pm >= 64) { const int rs = row - MP;
            float* o = out + (isv ? O_AVS : O_AKS) + (size_t)rs * 1024 + col;
            *(f32x4*)o = (f32x4){r[0], r[1], r[2], r[3]}; *(f32x4*)(o + 4) = (f32x4){r[4], r[5], r[6], r[7]};
            *(u32x4*)((isv ? AVS : AKS) + ((size_t)(rs >> 6) * 576 + 512 + (rs & 63)) * 1024 + col) = pack8(r);
        } else if ((u.pm & 15) >= 14) { const int b = u.pm >> 4, srel = (row & 4095) - 3584;
            float* o = out + (isv ? O_AVP : O_AKP) + ((size_t)b * 512 + srel) * 1024 + col;
            *(f32x4*)o = (f32x4){r[0], r[1], r[2], r[3]}; *(f32x4*)(o + 4) = (f32x4){r[4], r[5], r[6], r[7]};
        }
    }
    DI void operator()(AccRef acc, const Unit& u, int wr, int wc, int fr_, int fq_) const {
        int ln = __builtin_amdgcn_mbcnt_hi(~0u, __builtin_amdgcn_mbcnt_lo(~0u, 0u)); asm volatile("" : "+v"(ln));
        const int fr = ln & 15, fq = ln >> 4;
        const int pn = u.pn, cw = wc * 32 + 8 * fq;
        const int row0 = u.pm * 256 + wr * 64 + fr;
        if (pn < 16 && (pn >> 2) != 2) {
            const int kind = pn >> 2, lrow0 = wr * 64 + fr;
#pragma unroll
            for (int ai = 0; ai < 2; ++ai)
#pragma unroll
                for (int m = 0; m < 4; ++m)
#pragma unroll
                    for (int bj = 0; bj < 2; ++bj) {
                        const pg8::f32x4 k0 = acc[ai][bj][m][0], k1 = acc[ai][bj][m][1];
                        float ss = k0[0] * k0[0] + k0[1] * k0[1] + k0[2] * k0[2] + k0[3] * k0[3] + k1[0] * k1[0] + k1[1] * k1[1] + k1[2] * k1[2] + k1[3] * k1[3];
                        ss += __shfl_xor(ss, 16); ss += __shfl_xor(ss, 32);
                        if (fq == 0) xch[((ai * 128 + m * 16 + lrow0) * 2 + bj) * 4 + wc] = ss;
                    }
            asm volatile("s_waitcnt lgkmcnt(0)\n\ts_barrier" ::: "memory");
            const float* gp = gtab + (kind == 3 ? 2 : kind) * 128 + cw;
            const f32x4 g0 = *(const f32x4*)gp, g1 = *(const f32x4*)(gp + 4);
            bf16* dbase; int ldd, co0, co1;
            if (kind == 3) { dbase = BQ; ldd = 1536; co0 = ((pn - 12) * 2) * 192 + cw; co1 = co0 + 192; }
            else { dbase = AQ + (size_t)kind * AQ_ELEMS; ldd = 1024; co0 = (pn & 3) * 256 + cw; co1 = co0 + 128; }
            const bool docache = kind == 1 && (u.pm >= 64 || (u.pm & 15) >= 14);
#pragma unroll
            for (int ai = 0; ai < 2; ++ai)
#pragma unroll
                for (int m = 0; m < 4; ++m) {
                    const int row = row0 + ai * 128 + m * 16;
                    const f32x4 pa = *(const LAS f32x4*)(xch + ((ai * 128 + m * 16 + lrow0) * 2) * 4), pb = *(const LAS f32x4*)(xch + ((ai * 128 + m * 16 + lrow0) * 2 + 1) * 4);
#pragma unroll
                    for (int bj = 0; bj < 2; ++bj) {
                        const f32x4 p = bj ? pb : pa;
                        const float rstd = rsqrtf(((p[0] + p[1]) + (p[2] + p[3])) * (1.0f / 128.0f) + EPS);
                        const pg8::f32x4 k0 = acc[ai][bj][m][0] * rstd * g0, k1 = acc[ai][bj][m][1] * rstd * g1;
                        u32x4 w; w.x = pk2(k0[0], k0[1]); w.y = pk2(k0[2], k0[3]); w.z = pk2(k1[0], k1[1]); w.w = pk2(k1[2], k1[3]);
                        *(u32x4*)(dbase + (size_t)row * ldd + (bj ? co1 : co0)) = w;
                        if (docache) { const float r[8] = {k0[0], k0[1], k0[2], k0[3], k1[0], k1[1], k1[2], k1[3]}; cache_out(r, u, row, bj ? co1 : co0, false); }
                    }
                }
            return;
        }
        bf16* base; int ldc; int coff[2]; bool mapped = false, sig = false; bool valid[2] = {true, true};
        if (pn < 12) { base = AQ + (size_t)(pn >> 2) * AQ_ELEMS; ldc = 1024; coff[0] = (pn & 3) * 256 + cw; coff[1] = coff[0] + 128; }
        else if (pn < 16) { base = BQ; ldc = 1536; coff[0] = ((pn - 12) * 2) * 192 + cw; coff[1] = coff[0] + 192; }
        else if (pn < 18) { base = BQ; ldc = 1536;
            coff[0] = ((pn - 16) * 4 + (cw >> 6)) * 192 + 128 + (cw & 63); coff[1] = coff[0] + 2 * 192; }
        else if (pn < 20) { base = CKV; ldc = 512; mapped = true; coff[0] = (pn - 18) * 256 + cw; coff[1] = coff[0] + 128; }
        else if (pn == 20) { base = KR; ldc = 64; mapped = true; coff[0] = cw; coff[1] = cw + 128; valid[0] = cw < 64; valid[1] = false; }
        else { base = GA + (size_t)((pn - 21) >> 3) * GA_ELEMS; ldc = 1024; sig = true; coff[0] = ((pn - 21) & 7) * 256 + cw; coff[1] = coff[0] + 128; }
#pragma unroll
        for (int ai = 0; ai < 2; ++ai)
#pragma unroll
            for (int m = 0; m < 4; ++m) {
                const int row = row0 + ai * 128 + m * 16;
                const int rr = mapped ? rmap_row(row) : row;
                bf16* rowp = base + (size_t)rr * ldc;
#pragma unroll
                for (int bj = 0; bj < 2; ++bj) {
                    if (!valid[bj]) continue;
                    pg8::f32x4 v0 = acc[ai][bj][m][0], v1 = acc[ai][bj][m][1];
                    if (sig) {
                        unsigned w0 = 0u, w1 = 0u;
#pragma unroll
                        for (int j = 0; j < 4; ++j) { w0 = __builtin_amdgcn_cvt_pk_u8_f32(sigmoidf_(v0[j]) * 255.0f, j, w0); w1 = __builtin_amdgcn_cvt_pk_u8_f32(sigmoidf_(v1[j]) * 255.0f, j, w1); }
                        *(u32x2*)((unsigned char*)rowp + coff[bj]) = (u32x2){w0, w1};
                        continue;
                    }
                    u32x4 w; w.x = pk2(v0[0], v0[1]); w.y = pk2(v0[2], v0[3]); w.z = pk2(v1[0], v1[1]); w.w = pk2(v1[2], v1[3]);
                    *(u32x4*)(rowp + coff[bj]) = w;
                    if (pn >= 8 && pn < 12) { float r[8]; unpack8(w, r); cache_out(r, u, row, coff[bj], true); }
                }
            }
    }
};

struct EpiExpand {
    static constexpr bool PERM = true, AFTER_DRAIN = false;
    bf16 *KN, *VB; const float* g_kn; LAS float* xch;
    DI void operator()(AccRef acc, const Unit& u, int wr, int wc, int fr, int fq) const {
        const int col = u.pn * 128 + wc * 32 + 8 * fq;
        const int row0 = u.pm * 256 + wr * 64 + fr, lrow0 = wr * 64 + fr;
#pragma unroll
        for (int ai = 0; ai < 2; ++ai)
#pragma unroll
            for (int m = 0; m < 4; ++m) {
                const pg8::f32x4 k0 = acc[ai][0][m][0], k1 = acc[ai][0][m][1];
                float ss = k0[0] * k0[0] + k0[1] * k0[1] + k0[2] * k0[2] + k0[3] * k0[3] + k1[0] * k1[0] + k1[1] * k1[1] + k1[2] * k1[2] + k1[3] * k1[3];
                ss += __shfl_xor(ss, 16); ss += __shfl_xor(ss, 32);
                if (fq == 0) xch[(ai * 128 + m * 16 + lrow0) * 4 + wc] = ss;
                const pg8::f32x4 v0 = acc[ai][1][m][0], v1 = acc[ai][1][m][1];
                u32x4 w; w.x = pk2(v0[0], v0[1]); w.y = pk2(v0[2], v0[3]); w.z = pk2(v1[0], v1[1]); w.w = pk2(v1[2], v1[3]);
                *(u32x4*)(VB + (size_t)(row0 + ai * 128 + m * 16) * 1024 + col) = w;
            }
        asm volatile("s_waitcnt lgkmcnt(0)\n\ts_barrier" ::: "memory");
        const f32x4 g0 = *(const f32x4*)(g_kn + wc * 32 + 8 * fq), g1 = *(const f32x4*)(g_kn + wc * 32 + 8 * fq + 4);
#pragma unroll
        for (int ai = 0; ai < 2; ++ai)
#pragma unroll
            for (int m = 0; m < 4; ++m) {
                const f32x4 p = *(const LAS f32x4*)(xch + (ai * 128 + m * 16 + lrow0) * 4);
                const float rstd = rsqrtf(((p[0] + p[1]) + (p[2] + p[3])) * (1.0f / 128.0f) + EPS);
                const pg8::f32x4 k0 = acc[ai][0][m][0], k1 = acc[ai][0][m][1];
                u32x4 w; w.x = pk2(k0[0] * rstd * g0[0], k0[1] * rstd * g0[1]); w.y = pk2(k0[2] * rstd * g0[2], k0[3] * rstd * g0[3]);
                w.z = pk2(k1[0] * rstd * g1[0], k1[1] * rstd * g1[1]); w.w = pk2(k1[2] * rstd * g1[2], k1[3] * rstd * g1[3]);
                *(u32x4*)(KN + (size_t)(row0 + ai * 128 + m * 16) * 1024 + col) = w;
            }
    }
};

DI void unpack8_u8(u32x2 w, float* f) {
    const float k = 1.0f / 255.0f;
    f[0] = (float)(w.x & 255u) * k; f[1] = (float)((w.x >> 8) & 255u) * k; f[2] = (float)((w.x >> 16) & 255u) * k; f[3] = (float)(w.x >> 24) * k;
    f[4] = (float)(w.y & 255u) * k; f[5] = (float)((w.y >> 8) & 255u) * k; f[6] = (float)((w.y >> 16) & 255u) * k; f[7] = (float)(w.y >> 24) * k;
}
struct EpiMerge {
    static constexpr bool PERM = true, AFTER_DRAIN = false;
    const unsigned char* G; bf16* MIX; int add;
    DI void operator()(AccRef acc, const Unit& u, int wr, int wc, int fr, int fq) const {
        const int col0 = u.pn * 256 + wc * 32 + 8 * fq;
        const int row0 = u.pm * 256 + wr * 64 + fr;
#pragma unroll
        for (int ai = 0; ai < 2; ++ai)
#pragma unroll
            for (int m = 0; m < 4; ++m) {
#pragma unroll
                for (int bj = 0; bj < 2; ++bj) {
                    const size_t o = (size_t)(row0 + ai * 128 + m * 16) * 2048 + col0 + bj * 128;
                    const pg8::f32x4 v0 = acc[ai][bj][m][0], v1 = acc[ai][bj][m][1];
                    float g[8], r[8]; unpack8_u8(*(const u32x2*)(G + o), g);
                    r[0] = g[0] * v0[0]; r[1] = g[1] * v0[1]; r[2] = g[2] * v0[2]; r[3] = g[3] * v0[3];
                    r[4] = g[4] * v1[0]; r[5] = g[5] * v1[1]; r[6] = g[6] * v1[2]; r[7] = g[7] * v1[3];
                    if (add) { float t[8]; unpack8(*(const u32x4*)(MIX + o), t);
#pragma unroll
                        for (int j = 0; j < 8; ++j) r[j] += t[j]; }
                    *(u32x4*)(MIX + o) = pack8(r);
                }
            }
    }
};

struct EpiRes {
    static constexpr bool PERM = true, AFTER_DRAIN = false;
    const float* xp; const float* xs; float* out; int inplace;
    DI void operator()(AccRef acc, const Unit& u, int wr, int wc, int fr, int fq) const {
        const int col0 = u.pn * 256 + wc * 32 + 8 * fq;
        const int row0 = u.pm * 256 + wr * 64 + fr;
#pragma unroll
        for (int ai = 0; ai < 2; ++ai)
#pragma unroll
            for (int m = 0; m < 4; ++m) {
                const int row = row0 + ai * 128 + m * 16;
                const float* srow = inplace ? (out + (size_t)row * 2048) : (row < MP ? xp + (size_t)row * 2048 : xs + (size_t)(row - MP) * 2048);
                float* orow = out + (size_t)row * 2048;
#pragma unroll
                for (int bj = 0; bj < 2; ++bj) {
                    const int c = col0 + bj * 128;
                    const pg8::f32x4 a0 = *(const pg8::f32x4*)(srow + c), a1 = *(const pg8::f32x4*)(srow + c + 4);
                    *(pg8::f32x4*)(orow + c) = a0 + acc[ai][bj][m][0];
                    *(pg8::f32x4*)(orow + c + 4) = a1 + acc[ai][bj][m][1];
                }
            }
    }
};

struct EpiH16 {
    static constexpr bool PERM = true, AFTER_DRAIN = false;
    const float* xp; bf16* H16;
    DI void operator()(AccRef acc, const Unit& u, int wr, int wc, int fr, int fq) const {
        const int col0 = u.pn * 256 + wc * 32 + 8 * fq;
        const int row0 = u.pm * 256 + wr * 64 + fr;
#pragma unroll
        for (int ai = 0; ai < 2; ++ai) {
            pg8::f32x4 sv[4][2][2];
#pragma unroll
            for (int m = 0; m < 4; ++m) { const float* srow = xp + (size_t)(row0 + ai * 128 + m * 16) * 2048;
#pragma unroll
                for (int bj = 0; bj < 2; ++bj) { const int cc = col0 + bj * 128; sv[m][bj][0] = __builtin_nontemporal_load((const pg8::f32x4*)(srow + cc)); sv[m][bj][1] = __builtin_nontemporal_load((const pg8::f32x4*)(srow + cc + 4)); } }
#pragma unroll
            for (int m = 0; m < 4; ++m) { bf16* orow = H16 + (size_t)(row0 + ai * 128 + m * 16) * 2048;
#pragma unroll
                for (int bj = 0; bj < 2; ++bj) { const pg8::f32x4 a0 = sv[m][bj][0] + acc[ai][bj][m][0], a1 = sv[m][bj][1] + acc[ai][bj][m][1];
                    u32x4 w; w.x = pk2(a0[0], a0[1]); w.y = pk2(a0[2], a0[3]); w.z = pk2(a1[0], a1[1]); w.w = pk2(a1[2], a1[3]);
                    *(u32x4*)(orow + col0 + bj * 128) = w; } }
        }
    }
};
struct EpiY {
    static constexpr bool PERM = true, AFTER_DRAIN = false;
    const bf16* H16; float* out; const float* rs2;
    DI void operator()(AccRef acc, const Unit& u, int wr, int wc, int fr, int fq) const {
        const int col0 = u.pn * 256 + wc * 32 + 8 * fq;
        const int row0 = u.pm * 256 + wr * 64 + fr;
#pragma unroll
        for (int ai = 0; ai < 2; ++ai) {
            u32x4 hv[4][2];
#pragma unroll
            for (int m = 0; m < 4; ++m)
#pragma unroll
                for (int bj = 0; bj < 2; ++bj) hv[m][bj] = __builtin_nontemporal_load((const u32x4*)(H16 + (size_t)(row0 + ai * 128 + m * 16) * 2048 + col0 + bj * 128));
#pragma unroll
            for (int m = 0; m < 4; ++m) { float* orow = out + (size_t)(row0 + ai * 128 + m * 16) * 2048; const float r2 = rs2[row0 + ai * 128 + m * 16];
#pragma unroll
                for (int bj = 0; bj < 2; ++bj) { float h[8]; unpack8(hv[m][bj], h); const int cc = col0 + bj * 128;
                    *(pg8::f32x4*)(orow + cc) = (pg8::f32x4){h[0], h[1], h[2], h[3]} + acc[ai][bj][m][0] * r2;
                    *(pg8::f32x4*)(orow + cc + 4) = (pg8::f32x4){h[4], h[5], h[6], h[7]} + acc[ai][bj][m][1] * r2; } }
        }
    }
};

struct EpiPartial {
    static constexpr bool PERM = true, AFTER_DRAIN = false;
    float* part;
    DI void operator()(AccRef acc, const Unit& u, int wr, int wc, int fr, int fq) const {
        const int col0 = u.pn * 256 + wc * 32 + 8 * fq;
        const int row0 = u.pm * 256 + wr * 64 + fr;
        float* base = part + (size_t)u.ks * (MS * 2048);
#pragma unroll
        for (int ai = 0; ai < 2; ++ai)
#pragma unroll
            for (int m = 0; m < 4; ++m) {
                float* orow = base + (size_t)(row0 + ai * 128 + m * 16) * 2048 + col0;
#pragma unroll
                for (int bj = 0; bj < 2; ++bj) { *(pg8::f32x4*)(orow + bj * 128) = acc[ai][bj][m][0]; *(pg8::f32x4*)(orow + bj * 128 + 4) = acc[ai][bj][m][1]; }
            }
    }
};

struct EpiNull {
    static constexpr bool PERM = true, AFTER_DRAIN = false;
    float* sink;
    DI void operator()(AccRef acc, const Unit& u, int wr, int wc, int fr, int fq) const {
        float s = 0.f;
#pragma unroll
        for (int ai = 0; ai < 2; ++ai)
#pragma unroll
            for (int bj = 0; bj < 2; ++bj)
#pragma unroll
                for (int m = 0; m < 4; ++m) s += acc[ai][bj][m][0][0] + acc[ai][bj][m][1][3];
        if (s == 12345.678f) sink[0] = s;
    }
};

struct EpiUp {
    static constexpr bool PERM = true, AFTER_DRAIN = false;
    bf16* U;
    DI void operator()(AccRef acc, const Unit& u, int wr, int wc, int fr, int fq) const {
        const int col0 = u.pn * 256 + wc * 32 + 8 * fq;
        const int row0 = u.pm * 256 + wr * 64 + fr;
#pragma unroll
        for (int ai = 0; ai < 2; ++ai)
#pragma unroll
            for (int m = 0; m < 4; ++m) {
#pragma unroll
                for (int bj = 0; bj < 2; ++bj) {
                    const size_t o = (size_t)(row0 + ai * 128 + m * 16) * DFF + col0 + bj * 128;
                    pg8::f32x4 v0 = acc[ai][bj][m][0], v1 = acc[ai][bj][m][1];
#pragma unroll
                    for (int j = 0; j < 4; ++j) { float a = fmaxf(v0[j], 0.f), b = fmaxf(v1[j], 0.f); v0[j] = a * a; v1[j] = b * b; }
                    u32x4 w; w.x = pk2(v0[0], v0[1]); w.y = pk2(v0[2], v0[3]); w.z = pk2(v1[0], v1[1]); w.w = pk2(v1[2], v1[3]);
                    *(u32x4*)(U + o) = w;
                }
            }
    }
};

DI void transpose_tile(const float* __restrict__ W, int K, int N, int k0, int n0, bf16* WT, int n0dst, LAS float* scr, int tid) {
    { const int n = tid & 63, kb = tid >> 6;
#pragma unroll
      for (int i = 0; i < 8; ++i) scr[(kb + 8 * i) * 65 + n] = W[(size_t)(k0 + kb + 8 * i) * N + n0 + n]; }
    __syncthreads();
    { const int n = tid >> 3, kk = (tid & 7) * 8; float f[8];
#pragma unroll
      for (int j = 0; j < 8; ++j) f[j] = scr[(kk + j) * 65 + n];
      *(u32x4*)(WT + (size_t)(n0dst + n) * K + k0 + kk) = pack8(f); }
    __syncthreads();
}
DI void transpose_weight(const float* W, int K, int N, bf16* WT, LAS float* scr, int tid, int bid, int G, int& item_base, int mode) {
    const int nk = K / 64, cnt = nk * (N / 64);
    const int first = (bid - (item_base % G) + G) % G;
    for (int it = first; it < cnt; it += G) {
        const int nt = it / nk, kt = it % nk; const int n0 = nt * 64;
        int n0dst = n0;
        if (mode == 1) {
            if (n0 >= 3072 && n0 < 4608) { const int hd = (n0 - 3072) / 192, o = (n0 - 3072) % 192; n0dst = o < 128 ? 3072 + hd * 128 + o : 4096 + hd * 64 + (o - 128); }
            else if (n0 >= 5184) n0dst = n0 + 192;
        }
        transpose_tile(W, K, N, kt * 64, n0, WT, n0dst, scr, tid);
    }
    item_base += cnt;
}

DI void transpose_tile128(const float* __restrict__ W, int K, int N, int k0, int n0, bf16* WT, LAS float* scr, int tid, int mode, const float* kscale = nullptr) {
    { const int c4 = tid & 31, kr = tid >> 5; f32x4 v[4];
#pragma unroll
      for (int i = 0; i < 4; ++i) v[i] = *(const f32x4*)(W + (size_t)(k0 + kr + 16 * i) * N + n0 + 4 * c4);
      if (kscale) {
#pragma unroll
          for (int i = 0; i < 4; ++i) v[i] = v[i] * kscale[k0 + kr + 16 * i]; }
#pragma unroll
      for (int i = 0; i < 4; ++i) *(LAS f32x4*)(scr + (kr + 16 * i) * 132 + 4 * c4) = v[i]; }
    __syncthreads();
    { const int n = tid & 127, kk = (tid >> 7) * 16; float f[16];
#pragma unroll
      for (int j = 0; j < 16; ++j) f[j] = scr[(kk + j) * 132 + n];
      int nd = n0 + n;
      if (mode == 1) {
          const int nb = nd & ~63;
          if (nb >= 3072 && nb < 4608) { const int hd = (nb - 3072) / 192, o = (nb - 3072) % 192; nd = (o < 128 ? 3072 + hd * 128 + o : 4096 + hd * 64 + (o - 128)) + (nd & 63); }
          else if (nb >= 5184) nd += 192;
      }
      bf16* dst = WT + (size_t)nd * K + k0 + kk;
      *(u32x4*)dst = pack8(f); *(u32x4*)(dst + 8) = pack8(f + 8); }
    __syncthreads();
}
DI void transpose_weight128(const float* W, int K, int N, bf16* WT, LAS float* scr, int tid, int idx, int cnt, int mode = 0, int ncols = 0, const float* kscale = nullptr) {
    if (cnt <= 0) return;
    const int nk = K / 64, total = nk * ((ncols ? ncols : N) / 128);
    for (int it = idx; it < total; it += cnt) { const int nt = it / nk, kt = it % nk; transpose_tile128(W, K, N, kt * 64, nt * 128, WT, scr, tid, mode, kscale); }
}
DI void idle_share(int nwg, int& idx, int& cnt) {
    const int G = gridDim.x, rem = nwg % G, c = blockIdx.x;
    if (rem == 0) { idx = c; cnt = G; } else if (c >= rem) { idx = c - rem; cnt = G - rem; } else { idx = 0; cnt = 0; }
}
#define XB_TMO      128
#define XB_XCNT(j)  (256  + 64 * (j))
#define XB_XSUB(j)  (1280 + 64 * (j))
#define XB_XGEN(j)  (2304 + 64 * (j))
#define XB_TOP      3328
#define XB_TOPGEN   3392
#define XCD_BAR_WORDS 3456
#define XB_SPIN_CAP (1u << 18)

__device__ __forceinline__ unsigned xb_ld(unsigned* p)              { return __hip_atomic_load(p, __ATOMIC_RELAXED, __HIP_MEMORY_SCOPE_AGENT); }
__device__ __forceinline__ unsigned xb_add(unsigned* p, unsigned v) { return __hip_atomic_fetch_add(p, v, __ATOMIC_RELAXED, __HIP_MEMORY_SCOPE_AGENT); }
__device__ __forceinline__ unsigned xb_xcc_id() { return (unsigned)__builtin_amdgcn_s_getreg((3 << 11) | 20) & 0xFu; }
#define XB_SPIN(cond, bar) do { unsigned _sp = 0; while (cond) { __builtin_amdgcn_s_sleep(1); \
    if ((++_sp & 255u) == 0u) { if (xb_ld(&(bar)[XB_TMO])) break; if (_sp > XB_SPIN_CAP) { atomicAdd(&(bar)[XB_TMO], 1u); break; } } } } while (0)

struct XcdBarrier {
    unsigned* bar; unsigned x;
    volatile LAS unsigned* st;
};

__device__ __forceinline__ XcdBarrier xcd_barrier_post(unsigned* bar, volatile LAS unsigned* st) {
    XcdBarrier b; b.bar = bar; b.x = xb_xcc_id(); b.st = st;
    if (threadIdx.x == 0) (void)xb_add(&bar[XB_XCNT(b.x)], 1u);
    return b;
}
__device__ __forceinline__ void xcd_barrier_complete(unsigned* bar, unsigned x, unsigned& nloc, unsigned& nx) {
    const unsigned G = gridDim.x * gridDim.y * gridDim.z;
    unsigned sum, cnt, mine, sp = 0u;
    for (;;) {
        sum = 0u; cnt = 0u; mine = 0u;
#pragma unroll
        for (unsigned j = 0; j < 16; ++j) { const unsigned c = xb_ld(&bar[XB_XCNT(j)]); sum += c; cnt += (c > 0u) ? 1u : 0u; mine = (j == x) ? c : mine; }
        if (sum == G) break;
        __builtin_amdgcn_s_sleep(1);
        if ((++sp & 255u) == 0u) { if (xb_ld(&bar[XB_TMO])) break; if (sp > XB_SPIN_CAP) { atomicAdd(&bar[XB_TMO], 1u); break; } }
    }
    nloc = mine > 0u ? mine : 1u; nx = cnt > 0u ? cnt : 1u;
}

__device__ __forceinline__ void xcd_barrier(const XcdBarrier& b) {
    asm volatile("s_waitcnt vmcnt(0)" ::: "memory");
    __syncthreads();
    if (threadIdx.x == 0) {
        unsigned* bar = b.bar;
        __builtin_amdgcn_s_waitcnt(0);
        unsigned nloc = b.st[0], nx = b.st[1];
        if (nloc == 0u) { xcd_barrier_complete(bar, b.x, nloc, nx); b.st[0] = nloc; b.st[1] = nx; }
        const unsigned old = xb_add(&bar[XB_XSUB(b.x)], 1u);
        const unsigned gen = old / nloc;
        if (old + 1u == (gen + 1u) * nloc) {
            __builtin_amdgcn_fence(__ATOMIC_RELEASE, "agent");
            asm volatile("s_waitcnt vmcnt(0)" ::: "memory");
            const unsigned og = xb_add(&bar[XB_TOP], 1u);
            const unsigned tg = og / nx;
            if (og + 1u == (tg + 1u) * nx) xb_add(&bar[XB_TOPGEN], 1u);
            else XB_SPIN(xb_ld(&bar[XB_TOPGEN]) == tg, bar);
            __builtin_amdgcn_fence(__ATOMIC_ACQUIRE, "agent");
            xb_add(&bar[XB_XGEN(b.x)], 1u);
            asm volatile("s_waitcnt vmcnt(0)" ::: "memory");
        } else {
            XB_SPIN(xb_ld(&bar[XB_XGEN(b.x)]) == gen, bar);
            __builtin_amdgcn_fence(__ATOMIC_ACQUIRE, "agent");
            asm volatile("s_waitcnt vmcnt(0)" ::: "memory");
        }
    }
    __syncthreads();
}

DI void p0_prologue(const Args& a, LAS unsigned char* lds, int tid, int lane, int wave) {
    unsigned char* ws = a.ws;
    const int G = gridDim.x, bid = blockIdx.x;
    LAS float* scr = (LAS float*)lds;
    transpose_weight128(a.in[7], 2048, 9280, (bf16*)(ws + WS_WIN), scr, tid, bid, G, 1, 9216);
    for (int kt = bid; kt < 32; kt += G) transpose_tile(a.in[7], 2048, 9280, kt * 64, 9216, (bf16*)(ws + WS_WIN), 9216 + 192, scr, tid);
    transpose_weight128(a.in[16], 512, 2048, (bf16*)(ws + WS_WKVB), scr, tid, (bid + 64) % G, G);
    transpose_weight128(a.in[17], 1024, 2048, (bf16*)(ws + WS_WPA), scr, tid, (bid + 128) % G, G);
    transpose_weight128(a.in[18], 1024, 2048, (bf16*)(ws + WS_WPB), scr, tid, (bid + 192) % G, G);
    transpose_weight128(a.in[19], 2048, 2048, (bf16*)(ws + WS_WOUT), scr, tid, bid, G);
    if (tid < 384) { const int k = tid >> 7, e = tid & 127; float* gt = (float*)(ws + 16384);
        gt[tid] = k == 0 ? a.in[8][e] * QS_BAND : k == 1 ? a.in[9][e] : a.in[13][e] * QS_MLA; }
    { u32x4 z = {0u, 0u, 0u, 0u}; u32x4* p = (u32x4*)((bf16*)(ws + WS_WIN) + (size_t)5184 * 2048);
      for (int i = bid * 512 + tid; i < 49152; i += G * 512) p[i] = z; }
    const int gw = bid * 8 + wave, nw = G * 8;
    { const float* g = a.in[6]; bf16* XN = (bf16*)(ws + WS_XN);
      for (int row = gw; row < MT; row += nw) {
          const float* xr = row < MP ? a.in[0] + (size_t)row * 2048 : a.in[1] + (size_t)(row - MP) * 2048;
          f32x4 v[8]; float ss = 0.f;
#pragma unroll
          for (int i = 0; i < 8; ++i) { v[i] = ((const f32x4*)xr)[lane + 64 * i]; ss += v[i][0] * v[i][0] + v[i][1] * v[i][1] + v[i][2] * v[i][2] + v[i][3] * v[i][3]; }
          ss = wave_sum(ss); const float rstd = rsqrtf(ss * (1.0f / 2048.0f) + EPS);
#pragma unroll
          for (int i = 0; i < 8; ++i) { const f32x4 gv = ((const f32x4*)g)[lane + 64 * i];
              u32x2 w; w.x = pk2(v[i][0] * rstd * gv[0], v[i][1] * rstd * gv[1]); w.y = pk2(v[i][2] * rstd * gv[2], v[i][3] * rstd * gv[3]);
              *(u32x2*)(XN + (size_t)row * 2048 + 4 * (lane + 64 * i)) = w; }
      } }
}

DI void convert_caches(const Args& a, int idx, int cnt, int lane, int wave) {
    if (cnt <= 0) return;
    unsigned char* ws = a.ws; const int gw = idx * 8 + wave, nw = cnt * 8;
    { const float* cc = a.in[4]; const float* ck = a.in[5]; bf16* CKV = (bf16*)(ws + WS_CKV); bf16* KR = (bf16*)(ws + WS_KR);
      for (int r = gw; r < 8 * 2048; r += nw) {
          const int b = r >> 11, p = r & 2047; const size_t rr = (size_t)MP + (size_t)b * 2112 + p;
          const f32x4 v0 = ((const f32x4*)(cc + (size_t)r * 512))[2 * lane], v1 = ((const f32x4*)(cc + (size_t)r * 512))[2 * lane + 1];
          u32x4 w; w.x = pk2(v0[0], v0[1]); w.y = pk2(v0[2], v0[3]); w.z = pk2(v1[0], v1[1]); w.w = pk2(v1[2], v1[3]);
          *(u32x4*)(CKV + rr * 512 + 8 * lane) = w;
          KR[rr * 64 + lane] = tobf(ck[(size_t)r * 64 + lane]);
      } }
    { const float* ca = a.in[2]; const float* cv = a.in[3]; bf16* AKS = (bf16*)(ws + WS_AKS); bf16* AVS = (bf16*)(ws + WS_AVS);
      for (int r = gw; r < 8 * 512; r += nw) {
          const int b = r >> 9, p = r & 511; const size_t ro = ((size_t)b * 576 + p) * 1024 + 16 * lane;
          const f32x4* s0 = (const f32x4*)(ca + (size_t)r * 1024 + 16 * lane); const f32x4* s1 = (const f32x4*)(cv + (size_t)r * 1024 + 16 * lane);
#pragma unroll
          for (int h = 0; h < 2; ++h) {
              const f32x4 k0 = s0[2 * h], k1 = s0[2 * h + 1], v0 = s1[2 * h], v1 = s1[2 * h + 1];
              u32x4 w; w.x = pk2(k0[0], k0[1]); w.y = pk2(k0[2], k0[3]); w.z = pk2(k1[0], k1[1]); w.w = pk2(k1[2], k1[3]);
              *(u32x4*)(AKS + ro + 8 * h) = w;
              w.x = pk2(v0[0], v0[1]); w.y = pk2(v0[2], v0[3]); w.z = pk2(v1[0], v1[1]); w.w = pk2(v1[2], v1[3]);
              *(u32x4*)(AVS + ro + 8 * h) = w;
          }
      } }
}

DI void load16(const bf16* p, float* f) { unpack8(*(const u32x4*)p, f); unpack8(*(const u32x4*)(p + 8), f + 8); }
DI void store16(bf16* p, const float* f) { *(u32x4*)p = pack8(f); *(u32x4*)(p + 8) = pack8(f + 8); }
DI void storef16(float* p, const float* f) {
#pragma unroll
    for (int i = 0; i < 4; ++i) *(f32x4*)(p + 4 * i) = (f32x4){f[4 * i], f[4 * i + 1], f[4 * i + 2], f[4 * i + 3]};
}

DI void p2_norms(const Args& a, int lane, int wave) {
    unsigned char* ws = a.ws; float* out = a.out;
    bf16* BQ = (bf16*)(ws + WS_BQ); bf16* CKV = (bf16*)(ws + WS_CKV); bf16* KR = (bf16*)(ws + WS_KR);
    const float* g_kv = a.in[11]; const float* g_kr = a.in[12]; const float* g_qr = a.in[14];
    const int gw = blockIdx.x * 8 + wave, nw = gridDim.x * 8;
    const float gqr = g_qr[lane] * QS_MLA, gkr = g_kr[lane];
    float gkv[8];
#pragma unroll
    for (int j = 0; j < 8; ++j) gkv[j] = g_kv[lane * 8 + j];
    const float freq = exp2f(-(float)(lane & 31) * (13.287712379549449f / 32.0f));
    for (int row = gw; row < MT; row += nw) {
        const bool samp = row >= MP;
        const int s = samp ? (row - MP) & 63 : row & 4095;
        const int pos = samp ? 2048 + s : s;
        float rev = (float)pos * freq * 0.15915494309189535f; rev -= floorf(rev);
        const float cs = __builtin_amdgcn_cosf(rev), sn = __builtin_amdgcn_sinf(rev);
        const size_t rr = (size_t)rmap_row(row);
        bf16* pbr = BQ + (size_t)row * 1536 + 128 + lane; bf16* pck = CKV + rr * 512 + lane * 8; bf16* pkr = KR + rr * 64 + lane;
        float fc[8], xr[8];
#pragma unroll
        for (int hd = 0; hd < 8; ++hd) xr[hd] = bf1(pbr[hd * 192]);
        unpack8(*(const u32x4*)pck, fc);
        const float xk = bf1(*pkr);
#pragma unroll
        for (int hd = 0; hd < 8; ++hd) { const float x = xr[hd];
          const float ss = wave_sum(x * x); const float y = x * rsqrtf(ss * (1.0f / 64.0f) + EPS) * gqr; const float yp = __shfl_xor(y, 32);
          pbr[hd * 192] = tobf(lane < 32 ? y * cs - yp * sn : y * cs + yp * sn); }
        { float ss = 0.f;
#pragma unroll
          for (int j = 0; j < 8; ++j) ss += fc[j] * fc[j];
          ss = wave_sum(ss); const float rstd = rsqrtf(ss * (1.0f / 512.0f) + EPS);
#pragma unroll
          for (int j = 0; j < 8; ++j) fc[j] = fc[j] * rstd * gkv[j];
          *(u32x4*)pck = pack8(fc);
          float* o = samp ? out + O_CKS + (size_t)(row - MP) * 512 + lane * 8 : out + O_CKP + (size_t)row * 512 + lane * 8;
          *(f32x4*)o = (f32x4){fc[0], fc[1], fc[2], fc[3]}; *(f32x4*)(o + 4) = (f32x4){fc[4], fc[5], fc[6], fc[7]}; }
        { const float x = xk;
          const float ss = wave_sum(x * x); const float y = x * rsqrtf(ss * (1.0f / 64.0f) + EPS) * gkr; const float yp = __shfl_xor(y, 32);
          const float r = lane < 32 ? y * cs - yp * sn : y * cs + yp * sn;
          *pkr = tobf(r);
          if (samp) out[O_KRS + (size_t)(row - MP) * 64 + lane] = r; else out[O_KRP + (size_t)row * 64 + lane] = r; }
    }
}

DI void p5_knnorm(const Args& a, int lane, int wave) {
    bf16* KN = (bf16*)(a.ws + WS_KN); const float* g_kn = a.in[15];
    const int gw = blockIdx.x * 8 + wave, nw = gridDim.x * 8; const int sub = lane & 7;
    float g[16];
#pragma unroll
    for (int j = 0; j < 16; ++j) g[j] = g_kn[sub * 16 + j];
    for (int row = gw; row < RALL; row += nw) {
        float f[16]; bf16* p = KN + (size_t)row * 1024 + lane * 16; load16(p, f); float ss = 0.f;
#pragma unroll
        for (int j = 0; j < 16; ++j) ss += f[j] * f[j];
        ss += __shfl_xor(ss, 1); ss += __shfl_xor(ss, 2); ss += __shfl_xor(ss, 4);
        const float rstd = rsqrtf(ss * (1.0f / 128.0f) + EPS);
#pragma unroll
        for (int j = 0; j < 16; ++j) f[j] = f[j] * rstd * g[j];
        store16(p, f);
    }
}

DI void p10_hn(const Args& a, int lane, int wave) {
    float* rs2 = (float*)(a.ws + 32768); bf16* H16 = (bf16*)(a.ws + WS_H16);
    const int gw = blockIdx.x * 8 + wave, nw = gridDim.x * 8;
    for (int row = gw; row < MT; row += nw) {
        float ss = 0.f;
        if (row < MP) {
            const u32x4* hr = (const u32x4*)(H16 + (size_t)row * 2048);
            float t[4][8];
#pragma unroll
            for (int q = 0; q < 4; ++q) unpack8(hr[lane + 64 * q], t[q]);
#pragma unroll
            for (int q = 0; q < 4; ++q)
#pragma unroll
                for (int e = 0; e < 8; ++e) ss += t[q][e] * t[q][e];
        } else {
            f32x4 v[8];
            const float* xr = a.in[1] + (size_t)(row - MP) * 2048; const float* pr = (const float*)(a.ws + WS_PART1) + (size_t)(row - MP) * 2048;
#pragma unroll
            for (int i = 0; i < 8; ++i) { v[i] = ((const f32x4*)xr)[lane + 64 * i];
#pragma unroll
                for (int k = 0; k < 8; ++k) v[i] += ((const f32x4*)(pr + (size_t)k * (MS * 2048)))[lane + 64 * i];
                ((f32x4*)(a.out + (size_t)row * 2048))[lane + 64 * i] = v[i];
                u32x2 w; w.x = pk2(v[i][0], v[i][1]); w.y = pk2(v[i][2], v[i][3]);
                *(u32x2*)(H16 + (size_t)row * 2048 + 4 * (lane + 64 * i)) = w;
                const float b0 = bflo(w.x), b1 = bfhi(w.x), b2 = bflo(w.y), b3 = bfhi(w.y);
                ss += b0 * b0 + b1 * b1 + b2 * b2 + b3 * b3; }
        }
        ss = wave_sum(ss);
        if (lane == 0) rs2[row] = 1.0f / (ss * (1.0f / 2048.0f) + EPS);
    }
}

constexpr int AT_BUF = 40960, AT_V = 16384, AT_KR = 32768, AT_TAB = 122880;
#define MFMA32(a, b, c) __builtin_amdgcn_mfma_f32_32x32x16_bf16((a), (b), (c), 0, 0, 0)
#define GLDS16(gsrc, ldst) __builtin_amdgcn_global_load_lds((const unsigned*)(gsrc), (LAS unsigned*)(ldst), 16, 0, 0)
DI s16x4 vtr(const LAS unsigned char* p) { return __builtin_bit_cast(s16x4, __builtin_amdgcn_ds_read_tr16_b64_v4i16((LAS v4i16_t*)p)); }

struct AttnOffs { unsigned k[2], v[2], kr; };
template <bool MLA>
DI AttnOffs attn_offs(int kstride, int vstride, int wave, int lane) {
    AttnOffs o;
#pragma unroll
    for (int i = 0; i < 2; ++i) {
        const int p = 2 * wave + i;
        { const int row = 4 * p + (lane >> 4), c = (lane & 15) ^ (row & 15); o.k[i] = (unsigned)(row * kstride + c * 8) * 2u; }
        { const int sub = 2 * p + (lane >> 5), kb = sub >> 2, db = sub & 3, key = 8 * kb + ((lane & 31) >> 2), d = 32 * db + 8 * (lane & 3); o.v[i] = (unsigned)(key * vstride + d) * 2u; }
    }
    { const int row = 8 * wave + (lane >> 3), c = (lane & 7) ^ ((row >> 1) & 7); o.kr = (unsigned)(row * 64 + c * 8) * 2u; }
    return o;
}
template <bool MLA>
DI void attn_load_tile(LAS unsigned char* buf, const bf16* Kp, int kstride, const bf16* KRp, const bf16* Vp, int vstride, int t, int wave, const AttnOffs& o) {
    const char* kt = (const char*)(Kp + (size_t)t * 64 * kstride); const char* vt = (const char*)(Vp + (size_t)t * 64 * vstride);
#pragma unroll
    for (int i = 0; i < 2; ++i) {
        GLDS16(kt + o.k[i], buf + (2 * wave + i) * 1024);
        GLDS16(vt + o.v[i], buf + AT_V + (2 * wave + i) * 1024);
    }
    if (MLA) { const char* rt = (const char*)(KRp + (size_t)t * 64 * 64); GLDS16(rt + o.kr, buf + AT_KR + wave * 1024); }
}
#define AT_SYNC() asm volatile("s_waitcnt vmcnt(0) lgkmcnt(0)\n\ts_barrier" ::: "memory")

template <bool MLA>
DI void attn_unit(LAS unsigned char* lds, const bf16* Qp, int qstride, const bf16* Kp, int kstride, const bf16* KRp, const bf16* Vp, int vstride,
                  bf16* Op, int ostride, int t_lo, int t_hi, int qc, bool active, int wave, int lane) {
    constexpr int NKS = MLA ? 12 : 8;
    const int r = lane & 31, h = lane >> 5;
    bf16x8 qf[NKS];
    if (active) {
#pragma unroll
        for (int ks = 0; ks < NKS; ++ks) qf[ks] = *(const bf16x8*)(Qp + (size_t)(32 * wave + r) * qstride + 16 * ks + 8 * h);
    } else {
#pragma unroll
        for (int ks = 0; ks < NKS; ++ks) qf[ks] = (bf16x8){0, 0, 0, 0, 0, 0, 0, 0};
    }
    f32x16 o[4];
#pragma unroll
    for (int d = 0; d < 4; ++d)
#pragma unroll
        for (int i = 0; i < 16; ++i) o[d][i] = 0.f;
    float m_run = -1e30f, l_run = 0.f;
    const int kxor = h ^ (r & 15);
    const int koff = r * 256;
    const int krx = h ^ ((r >> 1) & 7);
    const int kroff = r * 128;
    const int voff = (4 * h + ((lane & 15) >> 2)) * 64 + ((lane >> 4) & 1) * 32 + (lane & 3) * 8;
    const LAS float* tab = (const LAS float*)(lds + AT_TAB);

    const AttnOffs offs = attn_offs<MLA>(kstride, vstride, wave, lane);
    constexpr int NP = MLA ? 5 : 4;
#define AT_BAR() asm volatile("s_waitcnt lgkmcnt(0)\n\ts_barrier" ::: "memory")
#define AT_WAITBAR(pre) do { if (pre) asm volatile("s_waitcnt vmcnt(%0) lgkmcnt(0)\n\ts_barrier" :: "i"(NP) : "memory"); else asm volatile("s_waitcnt vmcnt(0) lgkmcnt(0)\n\ts_barrier" ::: "memory"); } while (0)
    const int grp = wave >> 2, nt = t_hi - t_lo + 1;
    attn_load_tile<MLA>(lds, Kp, kstride, KRp, Vp, vstride, t_lo, wave, offs);
    if (nt > 1) attn_load_tile<MLA>(lds + AT_BUF, Kp, kstride, KRp, Vp, vstride, t_lo + 1, wave, offs);
    AT_SYNC();
    if (grp) AT_BAR();
    f32x16 s0, s1;
#pragma unroll
    for (int i = 0; i < 16; ++i) { s0[i] = 0.f; s1[i] = 0.f; }
    int bi = 0;
    for (int t = t_lo; t <= t_hi; ++t) {
        LAS unsigned char* buf = lds + bi * AT_BUF;
        LAS unsigned char* nbuf = lds + (bi == 0 ? 2 : bi - 1) * AT_BUF;
        bi = bi == 2 ? 0 : bi + 1;
        const bool pre = t + 2 <= t_hi;
        const bool doit = active && t <= qc && (MLA || t >= qc - 8);
        if (doit) {
#pragma unroll
            for (int i = 0; i < 16; ++i) { s0[i] = 0.f; s1[i] = 0.f; }
            {
                int kx = kxor, kr_ = krx; asm volatile("" : "+v"(kx), "+v"(kr_));
#define AT_KLD(ks, kt) ((ks) < 8 ? *(const LAS bf16x8*)(buf + (kt) * 8192 + koff + (((2 * (ks)) ^ kx) << 4)) \
                                 : *(const LAS bf16x8*)(buf + AT_KR + (kt) * 4096 + kroff + (((2 * ((ks) - 8)) ^ kr_) << 4)))
                bf16x8 ka[3][2];
                ka[0][0] = AT_KLD(0, 0); ka[0][1] = AT_KLD(0, 1); ka[1][0] = AT_KLD(1, 0); ka[1][1] = AT_KLD(1, 1);
#pragma unroll
                for (int ks = 0; ks < NKS; ++ks) {
                    if (ks + 2 < NKS) { ka[(ks + 2) % 3][0] = AT_KLD(ks + 2, 0); ka[(ks + 2) % 3][1] = AT_KLD(ks + 2, 1); }
                    __builtin_amdgcn_sched_barrier(0);
                    s0 = MFMA32(ka[ks % 3][0], qf[ks], s0); s1 = MFMA32(ka[ks % 3][1], qf[ks], s1);
                    __builtin_amdgcn_sched_barrier(0);
                }
#undef AT_KLD
            }
            if (!MLA) {
                const int delta = qc - t;
                if (delta >= 5) { const float c = tab[319];
#pragma unroll
                    for (int i = 0; i < 16; ++i) { s0[i] += c; s1[i] += c; }
                } else {
                    const int dbase = 64 * delta + (wave & 1) * 32 + r - 4 * h + 63;
#pragma unroll
                    for (int i = 0; i < 16; ++i) {
                        const int kk = (i & 3) + 8 * (i >> 2);
                        int i0 = dbase - kk; i0 = i0 > 319 ? 319 : i0;
                        int i1 = dbase - kk - 32; i1 = i1 > 319 ? 319 : i1;
                        s0[i] += tab[i0]; s1[i] += tab[i1];
                    }
                }
            }
        }
        if (grp) AT_WAITBAR(false); else AT_BAR();
        if (pre) attn_load_tile<MLA>(nbuf, Kp, kstride, KRp, Vp, vstride, t + 2, wave, offs);
        if (doit) {
            float mx = s0[0];
#pragma unroll
            for (int i = 1; i < 16; ++i) mx = fmaxf(mx, s0[i]);
#pragma unroll
            for (int i = 0; i < 16; ++i) mx = fmaxf(mx, s1[i]);
            mx = fmaxf(mx, __shfl_xor(mx, 32));
            const float m_new = fmaxf(m_run, mx);
            const float alpha = __builtin_amdgcn_exp2f(m_run - m_new);
            m_run = m_new;
            float ps = 0.f;
#pragma unroll
            for (int i = 0; i < 16; ++i) { s0[i] = __builtin_amdgcn_exp2f(s0[i] - m_new); s1[i] = __builtin_amdgcn_exp2f(s1[i] - m_new); ps += s0[i] + s1[i]; }
            l_run = l_run * alpha + ps;
#pragma unroll
            for (int d = 0; d < 4; ++d)
#pragma unroll
                for (int i = 0; i < 16; ++i) o[d][i] *= alpha;
#pragma unroll
            for (int kt = 0; kt < 2; ++kt) {
#pragma unroll
                for (int s = 0; s < 2; ++s) {
                    u32x4 pw;
                    if (kt == 0) { pw.x = pk2(s0[8 * s], s0[8 * s + 1]); pw.y = pk2(s0[8 * s + 2], s0[8 * s + 3]); pw.z = pk2(s0[8 * s + 4], s0[8 * s + 5]); pw.w = pk2(s0[8 * s + 6], s0[8 * s + 7]); }
                    else { pw.x = pk2(s1[8 * s], s1[8 * s + 1]); pw.y = pk2(s1[8 * s + 2], s1[8 * s + 3]); pw.z = pk2(s1[8 * s + 4], s1[8 * s + 5]); pw.w = pk2(s1[8 * s + 6], s1[8 * s + 7]); }
                    const bf16x8 pb = __builtin_bit_cast(bf16x8, pw);
#pragma unroll
                    for (int dt = 0; dt < 4; ++dt) {
                        const s16x4 lo = vtr(buf + AT_V + ((4 * kt + 2 * s) * 4 + dt) * 512 + voff);
                        const s16x4 hi = vtr(buf + AT_V + ((4 * kt + 2 * s + 1) * 4 + dt) * 512 + voff);
                        const bf16x8 va = __builtin_shufflevector(lo, hi, 0, 1, 2, 3, 4, 5, 6, 7);
                        o[dt] = MFMA32(va, pb, o[dt]);
                    }
                    __builtin_amdgcn_sched_barrier(0);
                }
            }
        }
        if (!grp) AT_WAITBAR(pre); else AT_BAR();
    }
    if (!grp) AT_BAR();
#undef AT_BAR
#undef AT_WAITBAR
    if (active) {
        const float lt = l_run + __shfl_xor(l_run, 32);
        const float inv = 1.0f / lt;
        int lane2 = lane; asm volatile("" : "+v"(lane2));
        bf16* orow = Op + (size_t)(32 * wave + (lane2 & 31)) * ostride + 4 * (lane2 >> 5);
#pragma unroll
        for (int dt = 0; dt < 4; ++dt)
#pragma unroll
            for (int g = 0; g < 4; ++g) {
                u32x2 w; w.x = pk2(o[dt][4 * g] * inv, o[dt][4 * g + 1] * inv); w.y = pk2(o[dt][4 * g + 2] * inv, o[dt][4 * g + 3] * inv);
                *(u32x2*)(orow + 32 * dt + 8 * g) = w;
            }
    }
}

DI void p3_band(const Args& a, LAS unsigned char* lds, int tid, int lane, int wave, int nrep) {
    unsigned char* ws = a.ws;
    bf16* AQ = (bf16*)(ws + WS_AQ); const bf16* AK = (const bf16*)(ws + WS_AK); const bf16* AV = (const bf16*)(ws + WS_AV);
    const bf16* AKS = (const bf16*)(ws + WS_AKS); const bf16* AVS = (const bf16*)(ws + WS_AVS);
    const float* rel = a.in[10];
    LAS float* tab = (LAS float*)(lds + AT_TAB);
#pragma unroll 1
    for (int rp = 0; rp < nrep; ++rp)
    for (int idx0 = blockIdx.x; idx0 < 576; idx0 += gridDim.x) {
        int idx = idx0;
        if (gridDim.x == 256 && idx0 < 512) { const int x = idx0 & 7, local = (idx0 >> 8) * 32 + ((idx0 >> 3) & 31); idx = ((4 * x + (local >> 4)) << 4) | (local & 15); }
        int b, hd, u = 0; const bool samp = idx >= 512;
        if (!samp) { u = idx & 15; hd = (idx >> 4) & 7; b = idx >> 7; } else { const int j = idx - 512; hd = j & 7; b = j >> 3; }
        if (tid < 320) tab[tid] = rel[hd * 320 + tid] * LOG2E;
        if (!samp) {
            const size_t rb = (size_t)b * 4096;
            bf16* Qp = AQ + (rb + 256 * u) * 1024 + hd * 128;
            const int t_lo = 4 * u - 8 > 0 ? 4 * u - 8 : 0;
            attn_unit<false>(lds, Qp, 1024, AK + rb * 1024 + hd * 128, 1024, nullptr, AV + rb * 1024 + hd * 128, 1024, Qp, 1024,
                             t_lo, 4 * u + 3, 4 * u + (wave >> 1), true, wave, lane);
        } else {
            bf16* Qp = AQ + ((size_t)MP + 64 * b) * 1024 + hd * 128;
            attn_unit<false>(lds, Qp, 1024, AKS + (size_t)b * 576 * 1024 + hd * 128, 1024, nullptr, AVS + (size_t)b * 576 * 1024 + hd * 128, 1024, Qp, 1024,
                             0, 8, 8, wave < 2, wave, lane);
        }
    }
}

DI void p6_mla(const Args& a, LAS unsigned char* lds, int lane, int wave, int nrep) {
    unsigned char* ws = a.ws;
    const bf16* BQ = (const bf16*)(ws + WS_BQ); const bf16* KN = (const bf16*)(ws + WS_KN); const bf16* KR = (const bf16*)(ws + WS_KR);
    const bf16* VB = (const bf16*)(ws + WS_VB); bf16* OB = (bf16*)(ws + WS_OB);
#pragma unroll 1
    for (int rp = 0; rp < nrep; ++rp) {
    for (int it0 = blockIdx.x; it0 < 256; it0 += gridDim.x) {
        const int it = (gridDim.x == 256) ? (((it0 & 7) * 4 + (it0 >> 6)) * 8 + ((it0 >> 3) & 7)) : it0;
        const int bh = it >> 3, slot = it & 7, b = bh >> 3, hd = bh & 7;
        const size_t rb = (size_t)b * 4096;
#pragma unroll 1
        for (int half = 0; half < 2; ++half) {
            const int u = slot < 7 ? (half ? 2 + slot : 15 - slot) : half;
            attn_unit<true>(lds, BQ + (rb + 256 * u) * 1536 + hd * 192, 1536, KN + rb * 1024 + hd * 128, 1024, KR + rb * 64, VB + rb * 1024 + hd * 128, 1024,
                            OB + (rb + 256 * u) * 1024 + hd * 128, 1024, 0, 4 * u + 3, 4 * u + (wave >> 1), true, wave, lane);
        }
        if (slot == 7) {
#pragma unroll 1
            for (int k = 0; k < 2; ++k) {
                const int j = 2 * bh + k, sb = j >> 3, shd = j & 7;
                const size_t kb = (size_t)MP + (size_t)sb * 2112;
                attn_unit<true>(lds, BQ + ((size_t)MP + 64 * sb) * 1536 + shd * 192, 1536, KN + kb * 1024 + shd * 128, 1024, KR + kb * 64, VB + kb * 1024 + shd * 128, 1024,
                                OB + ((size_t)MP + 64 * sb) * 1024 + shd * 128, 1024, 0, 32, 32, wave < 2, wave, lane);
            }
        }
    }
    }
}

#ifndef PROBE_REP
#define PROBE_REP 0
#endif
#ifndef SKEW_STEPS
#define SKEW_STEPS 0
#endif
template <class Epi>
DI void run_gemm(LAS unsigned char* lds, const bf16* A, const bf16* Bt, int M, int N, int K, const Epi& E) {
    for (int i = 0, n = SKEW_STEPS * (((int)blockIdx.x >> 3) & 3); i < n; ++i) __builtin_amdgcn_s_sleep(127);
    pg8::Gemm g{A, Bt, M, N, K, K, K}; pg8::StaticOrder S; S.init(M, N, (int)gridDim.x, (int)blockIdx.x);
    pg8::gemm_phase<Epi, pg8::StaticOrder, true, true>(lds, g, S, E);
}
template <class Epi>
DI void run_gemm_splitk(LAS unsigned char* lds, const bf16* A, const bf16* Bt, int M, int N, int Kfull, int nsplit, const Epi& E) {
    pg8::Gemm g{A, Bt, M, N, Kfull / nsplit, Kfull, Kfull}; pg8::SplitOrder S; S.init(M, N, nsplit, (int)gridDim.x, (int)blockIdx.x);
    pg8::gemm_phase<Epi, pg8::SplitOrder, true, true>(lds, g, S, E);
}

__global__ void __launch_bounds__(512, 2) mega_fwd(Args a) {
    extern __shared__ __attribute__((aligned(16))) unsigned char lds_raw[];
    LAS unsigned char* lds = (LAS unsigned char*)lds_raw;
    cg::grid_group grid = cg::this_grid();
    const int tid = threadIdx.x, lane = tid & 63, wave = __builtin_amdgcn_readfirstlane(tid >> 6);
    unsigned char* ws = a.ws;
    { volatile LAS unsigned* st0 = (volatile LAS unsigned*)(lds + 131072 + 2048); if (tid == 0) { st0[0] = 0u; st0[1] = 0u; } }
    __syncthreads();
    const XcdBarrier xbar = xcd_barrier_post((unsigned*)ws, (volatile LAS unsigned*)(lds + 131072 + 2048));
    const int lo = a.ph_lo, hi = a.ph_hi;
#define IN(k) (lo <= (k) && (k) < hi)
#define GRID_BAR() xcd_barrier(xbar)
#define SEAM(k) do { if ((k) == 0) grid.sync(); else GRID_BAR(); } while (0)

#define REPEAT(k) _Pragma("unroll") for (int it_ = 0; it_ < (1 + ((PROBE_REP >> (k)) & 1)); ++it_) if (it_ > 0 && ({ GRID_BAR(); false; })) {} else
    if (IN(0)) REPEAT(0) p0_prologue(a, lds, tid, lane, wave);
    SEAM(0);
    if (IN(1)) REPEAT(1) { EpiInProj E{(bf16*)(ws + WS_AQ), (bf16*)(ws + WS_BQ), (bf16*)(ws + WS_CKV), (bf16*)(ws + WS_KR), (bf16*)(ws + WS_GA), (bf16*)(ws + WS_AKS), (bf16*)(ws + WS_AVS), a.out, (const float*)(ws + 16384), (LAS float*)(lds + 131072 + 4096)};
        run_gemm(lds, (const bf16*)(ws + WS_XN), (const bf16*)(ws + WS_WIN), MT, NIN, 2048, E);
        if (it_ == 0) { int idx, cnt; idle_share((MT / 256) * (NIN / 256), idx, cnt); convert_caches(a, idx, cnt, lane, wave); } }
    SEAM(1);
    if (IN(2)) p2_norms(a, lane, wave);
    SEAM(2);
    if (IN(3)) { p3_band(a, lds, tid, lane, wave, 1 + ((PROBE_REP >> 3) & 1));
        EpiExpand E{(bf16*)(ws + WS_KN) + (size_t)32768 * 1024, (bf16*)(ws + WS_VTMP), a.in[15], (LAS float*)(lds + 131072 + 4096)};
        const int G = gridDim.x; const int cs = G >= 128 ? ((int)blockIdx.x - 64 + G) % G : (int)blockIdx.x;
        pg8::Gemm g{(const bf16*)(ws + WS_CKV) + (size_t)32768 * 512, (const bf16*)(ws + WS_WKVB), 512, 2048, 512, 512, 512}; pg8::SplitOrder S; S.init(512, 2048, 1, G, cs);
        pg8::gemm_phase<EpiExpand, pg8::SplitOrder, true, true>(lds, g, S, E); }
    SEAM(3);
    if (IN(4)) { { const u32x4* src = (const u32x4*)(ws + WS_VTMP); u32x4* dst = (u32x4*)((bf16*)(ws + WS_VB) + (size_t)32768 * 1024);
          for (int i = (int)blockIdx.x * 512 + tid; i < 65536; i += (int)gridDim.x * 512) dst[i] = src[i]; }
        EpiExpand E{(bf16*)(ws + WS_KN), (bf16*)(ws + WS_VB), a.in[15], (LAS float*)(lds + 131072 + 4096)};
        run_gemm(lds, (const bf16*)(ws + WS_CKV), (const bf16*)(ws + WS_WKVB), 32768, 2048, 512, E); }
    SEAM(4);
    if (IN(6)) p6_mla(a, lds, lane, wave, 1 + ((PROBE_REP >> 6) & 1));
    SEAM(6);
    if (IN(7)) REPEAT(7) { EpiMerge E{(const unsigned char*)(ws + WS_GA), (bf16*)(ws + WS_MIX), 0};
        run_gemm(lds, (const bf16*)(ws + WS_OA), (const bf16*)(ws + WS_WPA), MT, 2048, 1024, E);
        if (it_ == 0) { int idx, cnt; idle_share((MT / 256) * 8, idx, cnt); transpose_weight128(a.in[21], 2048, 8192, (bf16*)(ws + WS_WUP), (LAS float*)lds, tid, idx, cnt, 0, 0, a.in[20]); } }
    if (IN(8)) { EpiMerge E{(const unsigned char*)(ws + WS_GB), (bf16*)(ws + WS_MIX), 1};
        run_gemm(lds, (const bf16*)(ws + WS_OB), (const bf16*)(ws + WS_WPB), MT, 2048, 1024, E);
        { int idx, cnt; idle_share((MT / 256) * 8, idx, cnt); transpose_weight128(a.in[22], 8192, 2048, (bf16*)(ws + WS_WDN), (LAS float*)lds, tid, idx, cnt); } }
    SEAM(8);
    if (IN(9)) REPEAT(9) { EpiH16 E{a.in[0], (bf16*)(ws + WS_H16)};
        run_gemm(lds, (const bf16*)(ws + WS_MIX), (const bf16*)(ws + WS_WOUT), MP, 2048, 2048, E);
        EpiPartial E2{(float*)(ws + WS_PART1)};
        run_gemm_splitk(lds, (const bf16*)(ws + WS_MIX) + (size_t)MP * 2048, (const bf16*)(ws + WS_WOUT), MS, 2048, 2048, 8, E2); }
    SEAM(9);
    if (IN(10)) REPEAT(10) p10_hn(a, lane, wave);
    SEAM(10);
    if (IN(11)) REPEAT(11) { EpiUp E{(bf16*)(ws + WS_U)};
        run_gemm(lds, (const bf16*)(ws + WS_H16), (const bf16*)(ws + WS_WUP), MT, DFF, 2048, E); }
    SEAM(11);
    if (IN(12)) { EpiY E{(const bf16*)(ws + WS_H16), a.out, (const float*)(ws + 32768)};
        run_gemm(lds, (const bf16*)(ws + WS_U), (const bf16*)(ws + WS_WDN), MP, 2048, DFF, E);
        EpiPartial E2{(float*)(ws + WS_PART2)};
        run_gemm_splitk(lds, (const bf16*)(ws + WS_U) + (size_t)MP * DFF, (const bf16*)(ws + WS_WDN), MS, 2048, DFF, 16, E2); }
    SEAM(12);
    if (IN(13)) {
        const int gw = blockIdx.x * 8 + wave, nw = gridDim.x * 8;
        for (int r = gw; r < MS * 8; r += nw) {
            const int row = r >> 3, cg_ = r & 7; const size_t o = (size_t)row * 2048 + cg_ * 256 + lane * 4;
            f32x4 v = *(const f32x4*)(a.out + (size_t)MP * 2048 + o); const float* pr = (const float*)(ws + WS_PART2) + o;
            f32x4 d = *(const f32x4*)pr;
#pragma unroll
            for (int k = 1; k < 16; ++k) d += *(const f32x4*)(pr + (size_t)k * (MS * 2048));
            *(f32x4*)(a.out + (size_t)MP * 2048 + o) = v + d * ((const float*)(ws + 32768))[MP + row];
        }
    }
#undef REPEAT
#undef IN
#undef SEAM
}

extern "C" void kernel_launch(void* const* d_in, const int* in_sizes, int n_in, void* d_out, int out_size, void* d_ws, size_t ws_size, hipStream_t stream) {
    static int grid = 0;
    if (grid == 0) {
        int dev = 0, cus = 0, per_cu = 0;
        (void)hipGetDevice(&dev);
        (void)hipDeviceGetAttribute(&cus, hipDeviceAttributeMultiprocessorCount, dev);
        if (hipFuncSetAttribute((const void*)mega_fwd, hipFuncAttributeMaxDynamicSharedMemorySize, LDS_BYTES) != hipSuccess) fprintf(stderr, "kernel_launch: hipFuncSetAttribute failed\n");
        if (hipOccupancyMaxActiveBlocksPerMultiprocessor(&per_cu, (const void*)mega_fwd, 512, LDS_BYTES) != hipSuccess || per_cu < 1) { fprintf(stderr, "kernel_launch: occupancy query gave %d\n", per_cu); per_cu = 1; }
        (void)hipGetLastError();
        if (per_cu > 1) per_cu = 1;
        grid = cus * per_cu;
        if (ws_size < WS_END) fprintf(stderr, "kernel_launch: workspace too small: %zu < %zu\n", ws_size, (size_t)WS_END);
        if (n_in != 23) fprintf(stderr, "kernel_launch: expected 23 inputs, got %d\n", n_in);
    }
    Args a{};
    for (int i = 0; i < 23; ++i) a.in[i] = (const float*)d_in[i];
    a.out = (float*)d_out; a.ws = (unsigned char*)d_ws; a.ph_lo = 0; a.ph_hi = 14; a.rep = 0; a.pad = 0;
    (void)hipMemsetAsync(d_ws, 0, 16384, stream);
    void* args[] = {&a};
    hipError_t e = hipLaunchCooperativeKernel((const void*)mega_fwd, dim3(grid), dim3(512), args, LDS_BYTES, stream);
    if (e != hipSuccess) fprintf(stderr, "kernel_launch: cooperative launch failed: %s (grid %d)\n", hipGetErrorString(e), grid);
}
```

```cpp
#include <hip/hip_runtime.h>
#include <hip/hip_cooperative_groups.h>
#include <cstdio>
#include <cstdint>
namespace cg = cooperative_groups;
namespace pg8 {
#define PG8_LAS __attribute__((address_space(3)))
typedef unsigned short bf16_t;
typedef short bf16x8 __attribute__((ext_vector_type(8)));
typedef float f32x4 __attribute__((ext_vector_type(4)));
typedef unsigned u32x4 __attribute__((ext_vector_type(4)));
constexpr int BM = 256, BK = 64, HALF = 128, HTB = HALF * BK * 2  , STAGE_BYTES = 8 * HTB, NXCD = 8, WGM = 8;

__host__ __device__ __forceinline__ int lds_byte(int r, int c) { const int st = (r >> 4) * 2 + (c >> 5), rr = r & 15, cc = c & 31, ob = rr * 64 + cc * 2; return st * 1024 + (ob ^ (((ob >> 9) & 1) << 5)); }
__host__ __device__ __forceinline__ void stage_rc(int b, int& R, int& C) { const int st = b / 1024, sb = b % 1024, swz = sb ^ (((sb >> 9) & 1) << 5); R = (st >> 1) * 16 + swz / 64; C = (st & 1) * 32 + (swz % 64) / 2; }
__host__ __device__ __forceinline__ int perm32(int rho) { const int n = rho >> 4, i = rho & 15; return 8 * (i >> 2) + 4 * n + (i & 3); }

struct Unit { int pm, pn, ks; };
struct Gemm { const bf16_t* A; const bf16_t* Bt; int M, N, K, lda, ldb; };

struct StaticOrder {
    int nM, nN, nwg, G, c;
    __host__ __device__ void init(int M, int N, int G_, int c_) { nM = M / BM; nN = N / BM; nwg = nM * nN; G = G_; c = c_; }
    __host__ __device__ bool next(int i, Unit& u) const {
        const long L = (long)i * G + c; if (L >= nwg) return false;
        int wgid = (int)L; { const int q = nwg / NXCD, r = nwg % NXCD, xcd = wgid % NXCD, off = wgid / NXCD; wgid = (xcd < r ? xcd * (q + 1) : r * (q + 1) + (xcd - r) * q) + off; }
        const int nig = WGM * nN, gid = wgid / nig, fm = gid * WGM, gsz = (nM - fm) < WGM ? (nM - fm) : WGM;
        u.pm = fm + ((wgid % nig) % gsz); u.pn = (wgid % nig) / gsz; u.ks = 0; return true;
    }
    __device__ __forceinline__ void a_ready(const Unit&) const {}
    __device__ __forceinline__ void done(const Unit&) const {}
};

struct SplitOrder {
    int nM, nN, S, G, c;
    __host__ __device__ void init(int M, int N, int S_, int G_, int c_) { nM = M / BM; nN = N / BM; S = S_; G = G_; c = c_; }
    __host__ __device__ bool next(int i, Unit& u) const {
        const long L = (long)i * G + c; if (L >= (long)nM * nN * S) return false;
        u.ks = (int)(L % S); const int t = (int)(L / S); u.pn = t % nN; u.pm = t / nN; return true;
    }
    __device__ __forceinline__ void a_ready(const Unit&) const {}
    __device__ __forceinline__ void done(const Unit&) const {}
};
__device__ __forceinline__ unsigned cvt_pk_bf16(float lo, float hi) { unsigned r; asm volatile("v_cvt_pk_bf16_f32 %0, %1, %2" : "=v"(r) : "v"(lo), "v"(hi)); return r; }
template <class Epi, class Sched, bool ALIGN_EPI = false, bool SP2 = false>
__device__ __forceinline__ void gemm_phase(PG8_LAS unsigned char* lds, const Gemm g, const Sched& S, const Epi& E) {
    const int tid = threadIdx.x, wid = __builtin_amdgcn_readfirstlane(tid >> 6), lane = tid & 63, wr = wid >> 2, wc = wid & 3, fr = lane & 15, fq = lane >> 4;
    const int K = g.K, nt = K / BK;
    unsigned voffA[2], voffB[2];
#pragma unroll
    for (int i = 0; i < 2; ++i) { int R, C; stage_rc(tid * 16 + i * 8192, R, C); const int Rb = Epi::PERM ? ((R & ~31) + perm32(R & 31)) : R;
        voffA[i] = (unsigned)(R * g.lda + C) * 2u; voffB[i] = (unsigned)(Rb * g.ldb + C) * 2u; }
    const size_t kstep = (size_t)(BK * 2);
    const size_t hstepA = (size_t)HALF * g.lda * 2, hstepB = (size_t)HALF * g.ldb * 2;
    const size_t tstepA = 2 * hstepA, tstepB = 2 * hstepB, sstep = (size_t)K * 2;
    const unsigned ldsw = (unsigned)wid * 1024u;
    const int aoff = lds_byte(wr * 64 + fr, fq * 8), boff = lds_byte(wc * 32 + fr, fq * 8);
#define PG8_SA(b, h) (((b) * 2 + (h)) * HTB)
#define PG8_SB(b, h) ((4 + (b) * 2 + (h)) * HTB)
#define PG8_STAGE(bufoff, gbase, voff) do { _Pragma("unroll") for (int _i = 0; _i < 2; ++_i) \
        __builtin_amdgcn_global_load_lds((const unsigned*)((const char*)(gbase) + (voff)[_i]), (PG8_LAS unsigned*)(lds + (bufoff) + ldsw + _i * 8192), 16, 0, 0); } while (0)
#define PG8_LDA(dst, b, h) do { _Pragma("unroll") for (int m = 0; m < 4; ++m) _Pragma("unroll") for (int k = 0; k < 2; ++k) dst[m][k] = *(const PG8_LAS bf16x8*)(lds + PG8_SA(b, h) + aoff + m * 2048 + k * 1024); } while (0)
#define PG8_LDB(dst, b, h) do { _Pragma("unroll") for (int n = 0; n < 2; ++n) _Pragma("unroll") for (int k = 0; k < 2; ++k) dst[n][k] = *(const PG8_LAS bf16x8*)(lds + PG8_SB(b, h) + boff + n * 2048 + k * 1024); } while (0)
#define PG8_MMA(ai, bj, At, Bt) do { __builtin_amdgcn_s_setprio(1); _Pragma("unroll") for (int m = 0; m < 4; ++m) _Pragma("unroll") for (int n = 0; n < 2; ++n) _Pragma("unroll") for (int k = 0; k < 2; ++k) \
        acc[ai][bj][m][n] = __builtin_amdgcn_mfma_f32_16x16x32_bf16(Bt[n][k], At[m][k], acc[ai][bj][m][n], 0, 0, 0); __builtin_amdgcn_s_setprio(0); } while (0)
#define PG8_WAIT_V(n) asm volatile("s_waitcnt vmcnt(" #n ")" ::: "memory")
#define PG8_WAIT_L(n) asm volatile("s_waitcnt lgkmcnt(" #n ")" ::: "memory")
#define PG8_BAR __builtin_amdgcn_s_barrier()
#define PG8_SCHED __builtin_amdgcn_sched_barrier(0)
    Unit cur, nxt; int ui = 0;
    if (!S.next(0, cur)) return;
    f32x4 acc[2][2][4][2];
#pragma unroll
    for (int a = 0; a < 2; ++a)
#pragma unroll
        for (int b = 0; b < 2; ++b)
#pragma unroll
            for (int m = 0; m < 4; ++m)
#pragma unroll
                for (int n = 0; n < 2; ++n) acc[a][b][m][n] = (f32x4){0.f, 0.f, 0.f, 0.f};
    bf16x8 At[4][2], B0[2][2], B1[2][2];
    const char* cA = (const char*)g.A + (size_t)cur.pm * tstepA + (size_t)cur.ks * sstep; const char* cB = (const char*)g.Bt + (size_t)cur.pn * tstepB + (size_t)cur.ks * sstep;
    S.a_ready(cur);
    if constexpr (SP2) {
        PG8_STAGE(PG8_SB(0, 0), cB, voffB); PG8_STAGE(PG8_SB(0, 1), cB + hstepB, voffB); PG8_STAGE(PG8_SA(0, 0), cA, voffA); PG8_STAGE(PG8_SA(0, 1), cA + hstepA, voffA);
        if (wr == 1) PG8_BAR;
        PG8_WAIT_V(2); PG8_BAR;
        PG8_STAGE(PG8_SB(1, 0), cB + kstep, voffB); PG8_STAGE(PG8_SA(1, 0), cA + kstep, voffA); PG8_STAGE(PG8_SB(1, 1), cB + hstepB + kstep, voffB);
        PG8_WAIT_V(6); PG8_BAR;
    } else {
        PG8_STAGE(PG8_SB(0, 0), cB, voffB); PG8_STAGE(PG8_SA(0, 0), cA, voffA); PG8_STAGE(PG8_SB(0, 1), cB + hstepB, voffB); PG8_STAGE(PG8_SA(0, 1), cA + hstepA, voffA);
        if (wr == 1) PG8_BAR;
        PG8_WAIT_V(4); PG8_BAR;
        PG8_STAGE(PG8_SB(1, 0), cB + kstep, voffB); PG8_STAGE(PG8_SA(1, 0), cA + kstep, voffA); PG8_STAGE(PG8_SB(1, 1), cB + hstepB + kstep, voffB);
        PG8_WAIT_V(6); PG8_BAR;
    }
    for (;;) {
        const bool has_next = S.next(ui + 1, nxt);
        const char* nA = has_next ? (const char*)g.A + (size_t)nxt.pm * tstepA + (size_t)nxt.ks * sstep : cA; const char* nB = has_next ? (const char*)g.Bt + (size_t)nxt.pn * tstepB + (size_t)nxt.ks * sstep : cB;
        for (int t = 0; t < nt; t += 2) {
            const bool last = (t == nt - 2);
            const char* a1 = cA + (size_t)(t + 1) * kstep;
            const char* a2 = last ? nA : cA + (size_t)(t + 2) * kstep; const char* b2 = last ? nB : cB + (size_t)(t + 2) * kstep;
            const char* a3 = a2 + kstep; const char* b3 = b2 + kstep;
            if (last && has_next) S.a_ready(nxt);
            if constexpr (SP2) {
            PG8_LDB(B0, 0, 0); PG8_LDB(B1, 0, 1); PG8_SCHED; PG8_LDA(At, 0, 0); PG8_STAGE(PG8_SA(1, 1), a1 + hstepA, voffA);
            PG8_WAIT_V(8); PG8_WAIT_L(0); PG8_BAR; PG8_MMA(0, 0, At, B0); PG8_MMA(0, 1, At, B1); PG8_BAR; PG8_SCHED;
            PG8_LDA(At, 0, 1); PG8_STAGE(PG8_SB(0, 0), b2, voffB); PG8_STAGE(PG8_SB(0, 1), b2 + hstepB, voffB); PG8_STAGE(PG8_SA(0, 0), a2, voffA);
            PG8_WAIT_V(8); PG8_WAIT_L(0); PG8_BAR; PG8_MMA(1, 0, At, B0); PG8_MMA(1, 1, At, B1); PG8_BAR; PG8_SCHED;
            PG8_LDB(B0, 1, 0); PG8_LDB(B1, 1, 1); PG8_SCHED; PG8_LDA(At, 1, 0); PG8_STAGE(PG8_SA(0, 1), a2 + hstepA, voffA);
            PG8_WAIT_V(8); PG8_WAIT_L(0); PG8_BAR; PG8_MMA(0, 0, At, B0); PG8_MMA(0, 1, At, B1); PG8_BAR; PG8_SCHED;
            PG8_LDA(At, 1, 1); PG8_STAGE(PG8_SB(1, 0), b3, voffB); PG8_STAGE(PG8_SB(1, 1), b3 + hstepB, voffB); PG8_STAGE(PG8_SA(1, 0), a3, voffA);
            PG8_WAIT_V(8); PG8_WAIT_L(0); PG8_BAR; PG8_MMA(1, 0, At, B0); PG8_MMA(1, 1, At, B1); PG8_BAR; PG8_SCHED;
            } else {
            PG8_LDB(B0, 0, 0); PG8_SCHED; PG8_LDA(At, 0, 0); PG8_STAGE(PG8_SA(1, 1), a1 + hstepA, voffA);
            PG8_WAIT_L(8); PG8_BAR; PG8_WAIT_L(0); PG8_MMA(0, 0, At, B0); PG8_BAR; PG8_SCHED;
            PG8_LDB(B1, 0, 1); PG8_STAGE(PG8_SB(0, 0), b2, voffB);
            PG8_BAR; PG8_WAIT_L(0); PG8_MMA(0, 1, At, B1); PG8_BAR;
            PG8_LDA(At, 0, 1); PG8_STAGE(PG8_SA(0, 0), a2, voffA);
            PG8_BAR; PG8_WAIT_L(0); PG8_MMA(1, 0, At, B0); PG8_BAR; PG8_SCHED;
            PG8_STAGE(PG8_SB(0, 1), b2 + hstepB, voffB);
            PG8_WAIT_V(6); PG8_BAR; PG8_MMA(1, 1, At, B1); PG8_BAR;
            PG8_LDB(B0, 1, 0); PG8_SCHED; PG8_LDA(At, 1, 0); PG8_STAGE(PG8_SA(0, 1), a2 + hstepA, voffA);
            PG8_WAIT_L(8); PG8_BAR; PG8_WAIT_L(0); PG8_MMA(0, 0, At, B0); PG8_BAR; PG8_SCHED;
            PG8_LDB(B1, 1, 1); PG8_STAGE(PG8_SB(1, 0), b3, voffB);
            PG8_BAR; PG8_WAIT_L(0); PG8_MMA(0, 1, At, B1); PG8_BAR;
            PG8_LDA(At, 1, 1); PG8_STAGE(PG8_SA(1, 0), a3, voffA);
            PG8_BAR; PG8_WAIT_L(0); PG8_MMA(1, 0, At, B0); PG8_BAR; PG8_SCHED;
            PG8_STAGE(PG8_SB(1, 1), b3 + hstepB, voffB);
            PG8_WAIT_V(6); PG8_BAR; PG8_MMA(1, 1, At, B1); PG8_BAR;
            }
        }
        if constexpr (ALIGN_EPI) { if (wr == 0) PG8_BAR; }
        if constexpr (!Epi::AFTER_DRAIN) { E(acc, cur, wr, wc, fr, fq); S.done(cur); }
        if (!has_next) break;
#pragma unroll
        for (int a = 0; a < 2; ++a)
#pragma unroll
            for (int b = 0; b < 2; ++b)
#pragma unroll
                for (int m = 0; m < 4; ++m)
#pragma unroll
                    for (int n = 0; n < 2; ++n) acc[a][b][m][n] = (f32x4){0.f, 0.f, 0.f, 0.f};
        cur = nxt; cA = nA; cB = nB; ++ui;
        if constexpr (ALIGN_EPI) { if (wr == 1) PG8_BAR; }
    }
    PG8_WAIT_V(0);
    if constexpr (!ALIGN_EPI) { if (wr == 0) PG8_BAR; }
    PG8_BAR;
    if constexpr (Epi::AFTER_DRAIN) { E.fused(acc, cur, wr, wc, fr, fq, lds, wid, lane); S.done(cur); }
#undef PG8_SA
#undef PG8_SB
#undef PG8_STAGE
#undef PG8_LDA
#undef PG8_LDB
#undef PG8_MMA
#undef PG8_WAIT_V
#undef PG8_WAIT_L
#undef PG8_BAR
#undef PG8_SCHED
}
}

#define DI __device__ __forceinline__
#define LAS __attribute__((address_space(3)))
typedef unsigned short bf16;
typedef short bf16x8 __attribute__((ext_vector_type(8)));
typedef short s16x4 __attribute__((ext_vector_type(4)));
typedef short v4i16_t __attribute__((ext_vector_type(4)));
typedef float f32x16 __attribute__((ext_vector_type(16)));
typedef float f32x4 __attribute__((ext_vector_type(4)));
typedef unsigned u32x4 __attribute__((ext_vector_type(4)));
typedef unsigned u32x2 __attribute__((ext_vector_type(2)));
typedef float f32x2_t __attribute__((ext_vector_type(2)));
typedef __bf16 bf16x2_t __attribute__((ext_vector_type(2)));

constexpr int DM = 2048, MP = 16384, MS = 512, MT = 16896, NIN = 9472, DFF = 8192, RALL = 33280;
constexpr size_t MiB = 1048576;
constexpr size_t WS_WKVB = 1 * MiB, WS_WPA = 3 * MiB, WS_WPB = 7 * MiB, WS_WOUT = 11 * MiB, WS_WIN = 19 * MiB, WS_OB = 19 * MiB,
                 WS_XN = 56 * MiB, WS_KN = 56 * MiB, WS_MIX = 56 * MiB, WS_AQ = 122 * MiB, WS_AK = 155 * MiB, WS_AV = 188 * MiB, WS_VB = 155 * MiB,
                 WS_BQ = 221 * MiB, WS_CKV = 271 * MiB, WS_KR = 304 * MiB, WS_GA = 309 * MiB, WS_GB = 375 * MiB, WS_AKS = 441 * MiB, WS_AVS = 450 * MiB,
                 WS_OA = 122 * MiB, WS_VTMP = 460 * MiB, WS_PART1 = 221 * MiB, WS_PART2 = 1 * MiB, WS_H16 = 331 * MiB, WS_WUP = 448 * MiB, WS_WDN = 480 * MiB, WS_HN = 1 * MiB, WS_U = 67 * MiB, WS_END = 512 * MiB;
constexpr size_t AQ_ELEMS = (size_t)MT * 1024, GA_ELEMS = (size_t)MT * 2048;
constexpr size_t O_YP = 0, O_YS = 33554432, O_AKP = 34603008, O_AVP = 36700160, O_CKP = 38797312, O_KRP = 47185920,
                 O_AKS = 48234496, O_AVS = 48758784, O_CKS = 49283072, O_KRS = 49545216;
constexpr int LDS_BYTES = 143360;
constexpr float EPS = 1e-6f;
constexpr float LOG2E = 1.4426950408889634f;
constexpr float QS_BAND = 0.08838834764831845f * 1.4426950408889634f;
constexpr float QS_MLA = 0.07216878364870322f * 1.4426950408889634f;

DI unsigned pk2(float lo, float hi) { f32x2_t v = {lo, hi}; bf16x2_t b = __builtin_convertvector(v, bf16x2_t); return __builtin_bit_cast(unsigned, b); }
DI float bflo(unsigned w) { return __builtin_bit_cast(float, w << 16); }
DI float bfhi(unsigned w) { return __builtin_bit_cast(float, w & 0xffff0000u); }
DI float bf1(bf16 v) { return __builtin_bit_cast(float, ((unsigned)v) << 16); }
DI bf16 tobf(float f) { return (bf16)(pk2(f, 0.f) & 0xffffu); }
DI float wave_sum(float v) {
#pragma unroll
    for (int o = 32; o >= 1; o >>= 1) v += __shfl_xor(v, o);
    return v;
}
DI void unpack8(u32x4 w, float* f) { f[0] = bflo(w.x); f[1] = bfhi(w.x); f[2] = bflo(w.y); f[3] = bfhi(w.y); f[4] = bflo(w.z); f[5] = bfhi(w.z); f[6] = bflo(w.w); f[7] = bfhi(w.w); }
DI u32x4 pack8(const float* f) { u32x4 w; w.x = pk2(f[0], f[1]); w.y = pk2(f[2], f[3]); w.z = pk2(f[4], f[5]); w.w = pk2(f[6], f[7]); return w; }
DI float sigmoidf_(float x) { return __builtin_amdgcn_rcpf(1.0f + __builtin_amdgcn_exp2f(-x * LOG2E)); }

struct Args { const float* in[23]; float* out; unsigned char* ws; int ph_lo, ph_hi, rep, pad; };

using pg8::Unit;
typedef const pg8::f32x4 (&AccRef)[2][2][4][2];

DI int rmap_row(int row) { return row < MP ? row : MP + ((row - MP) >> 6) * 2112 + 2048 + ((row - MP) & 63); }

struct EpiInProj {
    static constexpr bool PERM = true, AFTER_DRAIN = false;
    bf16 *AQ, *BQ, *CKV, *KR, *GA; bf16 *AKS, *AVS; float* out; const float* gtab; LAS float* xch;
    DI void cache_out(const float* r, const Unit& u, int row, int col, bool isv) const {
        if (u.pm >= 64) { const int rs = row - MP;
            float* o = out + (isv ? O_AVS : O_AKS) + (size_t)rs * 1024 + col;
            *(f32x4*)o = (f32x4){r[0], r[1], r[2], r[3]}; *(f32x4*)(o + 4) = (f32x4){r[4], r[5], r[6], r[7]};
            *(u32x4*)((isv ? AVS : AKS) + ((size_t)(rs >> 6) * 576 + 512 + (rs & 63)) * 1024 + col) = pack8(r);
        } else if ((u.pm & 15) >= 14) { const int b = u.pm >> 4, srel = (row & 4095) - 3584;
            float* o = out + (isv ? O_AVP : O_AKP) + ((size_t)b * 512 + srel) * 1024 + col;
            *(f32x4*)o = (f32x4){r[0], r[1], r[2], r[3]}; *(f32x4*)(o + 4) = (f32x4){r[4], r[5], r[6], r[7]};
        }
    }
    DI void operator()(AccRef acc, const Unit& u, int wr, int wc, int fr_, int fq_) const {
        int ln = __builtin_amdgcn_mbcnt_hi(~0u, __builtin_amdgcn_mbcnt_lo(~0u, 0u)); asm volatile("" : "+v"(ln));
        const int fr = ln & 15, fq = ln >> 4;
        const int pn = u.pn, cw = wc * 32 + 8 * fq;
        const int row0 = u.pm * 256 + wr * 64 + fr;
        if (pn < 16 && (pn >> 2) != 2) {
            const int kind = pn >> 2, lrow0 = wr * 64 + fr;
#pragma unroll
            for (int ai = 0; ai < 2; ++ai)
#pragma unroll
                for (int m = 0; m < 4; ++m)
#pragma unroll
                    for (int bj = 0; bj < 2; ++bj) {
                        const pg8::f32x4 k0 = acc[ai][bj][m][0], k1 = acc[ai][bj][m][1];
                        float ss = k0[0] * k0[0] + k0[1] * k0[1] + k0[2] * k0[2] + k0[3] * k0[3] + k1[0] * k1[0] + k1[1] * k1[1] + k1[2] * k1[2] + k1[3] * k1[3];
                        ss += __shfl_xor(ss, 16); ss += __shfl_xor(ss, 32);
                        if (fq == 0) xch[((ai * 128 + m * 16 + lrow0) * 2 + bj) * 4 + wc] = ss;
                    }
            asm volatile("s_waitcnt lgkmcnt(0)\n\ts_barrier" ::: "memory");
            const float* gp = gtab + (kind == 3 ? 2 : kind) * 128 + cw;
            const f32x4 g0 = *(const f32x4*)gp, g1 = *(const f32x4*)(gp + 4);
            bf16* dbase; int ldd, co0, co1;
            if (kind == 3) { dbase = BQ; ldd = 1536; co0 = ((pn - 12) * 2) * 192 + cw; co1 = co0 + 192; }
            else { dbase = AQ + (size_t)kind * AQ_ELEMS; ldd = 1024; co0 = (pn & 3) * 256 + cw; co1 = co0 + 128; }
            const bool docache = kind == 1 && (u.pm >= 64 || (u.pm & 15) >= 14);
#pragma unroll
            for (int ai = 0; ai < 2; ++ai)
#pragma unroll
                for (int m = 0; m < 4; ++m) {
                    const int row = row0 + ai * 128 + m * 16;
                    const f32x4 pa = *(const LAS f32x4*)(xch + ((ai * 128 + m * 16 + lrow0) * 2) * 4), pb = *(const LAS f32x4*)(xch + ((ai * 128 + m * 16 + lrow0) * 2 + 1) * 4);
#pragma unroll
                    for (int bj = 0; bj < 2; ++bj) {
                        const f32x4 p = bj ? pb : pa;
                        const float rstd = rsqrtf(((p[0] + p[1]) + (p[2] + p[3])) * (1.0f / 128.0f) + EPS);
                        const pg8::f32x4 k0 = acc[ai][bj][m][0] * rstd * g0, k1 = acc[ai][bj][m][1] * rstd * g1;
                        u32x4 w; w.x = pk2(k0[0], k0[1]); w.y = pk2(k0[2], k0[3]); w.z = pk2(k1[0], k1[1]); w.w = pk2(k1[2], k1[3]);
                        *(u32x4*)(dbase + (size_t)row * ldd + (bj ? co1 : co0)) = w;
                        if (docache) { const float r[8] = {k0[0], k0[1], k0[2], k0[3], k1[0], k1[1], k1[2], k1[3]}; cache_out(r, u, row, bj ? co1 : co0, false); }
                    }
                }
            return;
        }
        bf16* base; int ldc; int coff[2]; bool mapped = false, sig = false; bool valid[2] = {true, true};
        if (pn < 12) { base = AQ + (size_t)(pn >> 2) * AQ_ELEMS; ldc = 1024; coff[0] = (pn & 3) * 256 + cw; coff[1] = coff[0] + 128; }
        else if (pn < 16) { base = BQ; ldc = 1536; coff[0] = ((pn - 12) * 2) * 192 + cw; coff[1] = coff[0] + 192; }
        else if (pn < 18) { base = BQ; ldc = 1536;
            coff[0] = ((pn - 16) * 4 + (cw >> 6)) * 192 + 128 + (cw & 63); coff[1] = coff[0] + 2 * 192; }
        else if (pn < 20) { base = CKV; ldc = 512; mapped = true; coff[0] = (pn - 18) * 256 + cw; coff[1] = coff[0] + 128; }
        else if (pn == 20) { base = KR; ldc = 64; mapped = true; coff[0] = cw; coff[1] = cw + 128; valid[0] = cw < 64; valid[1] = false; }
        else { base = GA + (size_t)((pn - 21) >> 3) * GA_ELEMS; ldc = 1024; sig = true; coff[0] = ((pn - 21) & 7) * 256 + cw; coff[1] = coff[0] + 128; }
#pragma unroll
        for (int ai = 0; ai < 2; ++ai)
#pragma unroll
            for (int m = 0; m < 4; ++m) {
                const int row = row0 + ai * 128 + m * 16;
                const int rr = mapped ? rmap_row(row) : row;
                bf16* rowp = base + (size_t)rr * ldc;
#pragma unroll
                for (int bj = 0; bj < 2; ++bj) {
                    if (!valid[bj]) continue;
                    pg8::f32x4 v0 = acc[ai][bj][m][0], v1 = acc[ai][bj][m][1];
                    if (sig) {
                        unsigned w0 = 0u, w1 = 0u;
#pragma unroll
                        for (int j = 0; j < 4; ++j) { w0 = __builtin_amdgcn_cvt_pk_u8_f32(sigmoidf_(v0[j]) * 255.0f, j, w0); w1 = __builtin_amdgcn_cvt_pk_u8_f32(sigmoidf_(v1[j]) * 255.0f, j, w1); }
                        *(u32x2*)((unsigned char*)rowp + coff[bj]) = (u32x2){w0, w1};
                        continue;
                    }
                    u32x4 w; w.x = pk2(v0[0], v0[1]); w.y = pk2(v0[2], v0[3]); w.z = pk2(v1[0], v1[1]); w.w = pk2(v1[2], v1[3]);
                    *(u32x4*)(rowp + coff[bj]) = w;
                    if (pn >= 8 && pn < 12) { float r[8]; unpack8(w, r); cache_out(r, u, row, coff[bj], true); }
                }
            }
    }
};

struct EpiExpand {
    static constexpr bool PERM = true, AFTER_DRAIN = false;
    bf16 *KN, *VB; const float* g_kn; LAS float* xch;
    DI void operator()(AccRef acc, const Unit& u, int wr, int wc, int fr, int fq) const {
        const int col = u.pn * 128 + wc * 32 + 8 * fq;
        const int row0 = u.pm * 256 + wr * 64 + fr, lrow0 = wr * 64 + fr;
#pragma unroll
        for (int ai = 0; ai < 2; ++ai)
#pragma unroll
            for (int m = 0; m < 4; ++m) {
                const pg8::f32x4 k0 = acc[ai][0][m][0], k1 = acc[ai][0][m][1];
                float ss = k0[0] * k0[0] + k0[1] * k0[1] + k0[2] * k0[2] + k0[3] * k0[3] + k1[0] * k1[0] + k1[1] * k1[1] + k1[2] * k1[2] + k1[3] * k1[3];
                ss += __shfl_xor(ss, 16); ss += __shfl_xor(ss, 32);
                if (fq == 0) xch[(ai * 128 + m * 16 + lrow0) * 4 + wc] = ss;
                const pg8::f32x4 v0 = acc[ai][1][m][0], v1 = acc[ai][1][m][1];
                u32x4 w; w.x = pk2(v0[0], v0[1]); w.y = pk2(v0[2], v0[3]); w.z = pk2(v1[0], v1[1]); w.w = pk2(v1[2], v1[3]);
                *(u32x4*)(VB + (size_t)(row0 + ai * 128 + m * 16) * 1024 + col) = w;
            }
        asm volatile("s_waitcnt lgkmcnt(0)\n\ts_barrier" ::: "memory");
        const f32x4 g0 = *(const f32x4*)(g_kn + wc * 32 + 8 * fq), g1 = *(const f32x4*)(g_kn + wc * 32 + 8 * fq + 4);
#pragma unroll
        for (int ai = 0; ai < 2; ++ai)
#pragma unroll
            for (int m = 0; m < 4; ++m) {
                const f32x4 p = *(const LAS f32x4*)(xch + (ai * 128 + m * 16 + lrow0) * 4);
                const float rstd = rsqrtf(((p[0] + p[1]) + (p[2] + p[3])) * (1.0f / 128.0f) + EPS);
                const pg8::f32x4 k0 = acc[ai][0][m][0], k1 = acc[ai][0][m][1];
                u32x4 w; w.x = pk2(k0[0] * rstd * g0[0], k0[1] * rstd * g0[1]); w.y = pk2(k0[2] * rstd * g0[2], k0[3] * rstd * g0[3]);
                w.z = pk2(k1[0] * rstd * g1[0], k1[1] * rstd * g1[1]); w.w = pk2(k1[2] * rstd * g1[2], k1[3] * rstd * g1[3]);
                *(u32x4*)(KN + (size_t)(row0 + ai * 128 + m * 16) * 1024 + col) = w;
            }
    }
};

DI void unpack8_u8(u32x2 w, float* f) {
    const float k = 1.0f / 255.0f;
    f[0] = (float)(w.x & 255u) * k; f[1] = (float)((w.x >> 8) & 255u) * k; f[2] = (float)((w.x >> 16) & 255u) * k; f[3] = (float)(w.x >> 24) * k;
    f[4] = (float)(w.y & 255u) * k; f[5] = (float)((w.y >> 8) & 255u) * k; f[6] = (float)((w.y >> 16) & 255u) * k; f[7] = (float)(w.y >> 24) * k;
}
struct EpiMerge {
    static constexpr bool PERM = true, AFTER_DRAIN = false;
    const unsigned char* G; bf16* MIX; int add;
    DI void operator()(AccRef acc, const Unit& u, int wr, int wc, int fr, int fq) const {
        const int col0 = u.pn * 256 + wc * 32 + 8 * fq;
        const int row0 = u.pm * 256 + wr * 64 + fr;
#pragma unroll
        for (int ai = 0; ai < 2; ++ai)
#pragma unroll
            for (int m = 0; m < 4; ++m) {
#pragma unroll
                for (int bj = 0; bj < 2; ++bj) {
                    const size_t o = (size_t)(row0 + ai * 128 + m * 16) * 2048 + col0 + bj * 128;
                    const pg8::f32x4 v0 = acc[ai][bj][m][0], v1 = acc[ai][bj][m][1];
                    float g[8], r[8]; unpack8_u8(*(const u32x2*)(G + o), g);
                    r[0] = g[0] * v0[0]; r[1] = g[1] * v0[1]; r[2] = g[2] * v0[2]; r[3] = g[3] * v0[3];
                    r[4] = g[4] * v1[0]; r[5] = g[5] * v1[1]; r[6] = g[6] * v1[2]; r[7] = g[7] * v1[3];
                    if (add) { float t[8]; unpack8(*(const u32x4*)(MIX + o), t);
#pragma unroll
                        for (int j = 0; j < 8; ++j) r[j] += t[j]; }
                    *(u32x4*)(MIX + o) = pack8(r);
                }
            }
    }
};

struct EpiRes {
    static constexpr bool PERM = true, AFTER_DRAIN = false;
    const float* xp; const float* xs; float* out; int inplace;
    DI void operator()(AccRef acc, const Unit& u, int wr, int wc, int fr, int fq) const {
        const int col0 = u.pn * 256 + wc * 32 + 8 * fq;
        const int row0 = u.pm * 256 + wr * 64 + fr;
#pragma unroll
        for (int ai = 0; ai < 2; ++ai)
#pragma unroll
            for (int m = 0; m < 4; ++m) {
                const int row = row0 + ai * 128 + m * 16;
                const float* srow = inplace ? (out + (size_t)row * 2048) : (row < MP ? xp + (size_t)row * 2048 : xs + (size_t)(row - MP) * 2048);
                float* orow = out + (size_t)row * 2048;
#pragma unroll
                for (int bj = 0; bj < 2; ++bj) {
                    const int c = col0 + bj * 128;
                    const pg8::f32x4 a0 = *(const pg8::f32x4*)(srow + c), a1 = *(const pg8::f32x4*)(srow + c + 4);
                    *(pg8::f32x4*)(orow + c) = a0 + acc[ai][bj][m][0];
                    *(pg8::f32x4*)(orow + c + 4) = a1 + acc[ai][bj][m][1];
                }
            }
    }
};

struct EpiH16 {
    static constexpr bool PERM = true, AFTER_DRAIN = false;
    const float* xp; bf16* H16;
    DI void operator()(AccRef acc, const Unit& u, int wr, int wc, int fr, int fq) const {
        const int col0 = u.pn * 256 + wc * 32 + 8 * fq;
        const int row0 = u.pm * 256 + wr * 64 + fr;
#pragma unroll
        for (int ai = 0; ai < 2; ++ai) {
            pg8::f32x4 sv[4][2][2];
#pragma unroll
            for (int m = 0; m < 4; ++m) { const float* srow = xp + (size_t)(row0 + ai * 128 + m * 16) * 2048;
#pragma unroll
                for (int bj = 0; bj < 2; ++bj) { const int cc = col0 + bj * 128; sv[m][bj][0] = *(const pg8::f32x4*)(srow + cc); sv[m][bj][1] = *(const pg8::f32x4*)(srow + cc + 4); } }
#pragma unroll
            for (int m = 0; m < 4; ++m) { bf16* orow = H16 + (size_t)(row0 + ai * 128 + m * 16) * 2048;
#pragma unroll
                for (int bj = 0; bj < 2; ++bj) { const pg8::f32x4 a0 = sv[m][bj][0] + acc[ai][bj][m][0], a1 = sv[m][bj][1] + acc[ai][bj][m][1];
                    u32x4 w; w.x = pk2(a0[0], a0[1]); w.y = pk2(a0[2], a0[3]); w.z = pk2(a1[0], a1[1]); w.w = pk2(a1[2], a1[3]);
                    *(u32x4*)(orow + col0 + bj * 128) = w; } }
        }
    }
};
struct EpiY {
    static constexpr bool PERM = true, AFTER_DRAIN = false;
    const bf16* H16; float* out; const float* rs2;
    DI void operator()(AccRef acc, const Unit& u, int wr, int wc, int fr, int fq) const {
        const int col0 = u.pn * 256 + wc * 32 + 8 * fq;
        const int row0 = u.pm * 256 + wr * 64 + fr;
#pragma unroll
        for (int ai = 0; ai < 2; ++ai) {
            u32x4 hv[4][2];
#pragma unroll
            for (int m = 0; m < 4; ++m)
#pragma unroll
                for (int bj = 0; bj < 2; ++bj) hv[m][bj] = *(const u32x4*)(H16 + (size_t)(row0 + ai * 128 + m * 16) * 2048 + col0 + bj * 128);
#pragma unroll
            for (int m = 0; m < 4; ++m) { float* orow = out + (size_t)(row0 + ai * 128 + m * 16) * 2048; const float r2 = rs2[row0 + ai * 128 + m * 16];
#pragma unroll
                for (int bj = 0; bj < 2; ++bj) { float h[8]; unpack8(hv[m][bj], h); const int cc = col0 + bj * 128;
                    *(pg8::f32x4*)(orow + cc) = (pg8::f32x4){h[0], h[1], h[2], h[3]} + acc[ai][bj][m][0] * r2;
                    *(pg8::f32x4*)(orow + cc + 4) = (pg8::f32x4){h[4], h[5], h[6], h[7]} + acc[ai][bj][m][1] * r2; } }
        }
    }
};

struct EpiPartial {
    static constexpr bool PERM = true, AFTER_DRAIN = false;
    float* part;
    DI void operator()(AccRef acc, const Unit& u, int wr, int wc, int fr, int fq) const {
        const int col0 = u.pn * 256 + wc * 32 + 8 * fq;
        const int row0 = u.pm * 256 + wr * 64 + fr;
        float* base = part + (size_t)u.ks * (MS * 2048);
#pragma unroll
        for (int ai = 0; ai < 2; ++ai)
#pragma unroll
            for (int m = 0; m < 4; ++m) {
                float* orow = base + (size_t)(row0 + ai * 128 + m * 16) * 2048 + col0;
#pragma unroll
                for (int bj = 0; bj < 2; ++bj) { *(pg8::f32x4*)(orow + bj * 128) = acc[ai][bj][m][0]; *(pg8::f32x4*)(orow + bj * 128 + 4) = acc[ai][bj][m][1]; }
            }
    }
};

struct EpiNull {
    static constexpr bool PERM = true, AFTER_DRAIN = false;
    float* sink;
    DI void operator()(AccRef acc, const Unit& u, int wr, int wc, int fr, int fq) const {
        float s = 0.f;
#pragma unroll
        for (int ai = 0; ai < 2; ++ai)
#pragma unroll
            for (int bj = 0; bj < 2; ++bj)
#pragma unroll
                for (int m = 0; m < 4; ++m) s += acc[ai][bj][m][0][0] + acc[ai][bj][m][1][3];
        if (s == 12345.678f) sink[0] = s;
    }
};

struct EpiUp {
    static constexpr bool PERM = true, AFTER_DRAIN = false;
    bf16* U;
    DI void operator()(AccRef acc, const Unit& u, int wr, int wc, int fr, int fq) const {
        const int col0 = u.pn * 256 + wc * 32 + 8 * fq;
        const int row0 = u.pm * 256 + wr * 64 + fr;
#pragma unroll
        for (int ai = 0; ai < 2; ++ai)
#pragma unroll
            for (int m = 0; m < 4; ++m) {
#pragma unroll
                for (int bj = 0; bj < 2; ++bj) {
                    const size_t o = (size_t)(row0 + ai * 128 + m * 16) * DFF + col0 + bj * 128;
                    pg8::f32x4 v0 = acc[ai][bj][m][0], v1 = acc[ai][bj][m][1];
#pragma unroll
                    for (int j = 0; j < 4; ++j) { float a = fmaxf(v0[j], 0.f), b = fmaxf(v1[j], 0.f); v0[j] = a * a; v1[j] = b * b; }
                    u32x4 w; w.x = pk2(v0[0], v0[1]); w.y = pk2(v0[2], v0[3]); w.z = pk2(v1[0], v1[1]); w.w = pk2(v1[2], v1[3]);
                    *(u32x4*)(U + o) = w;
                }
            }
    }
};

DI void transpose_tile(const float* __restrict__ W, int K, int N, int k0, int n0, bf16* WT, int n0dst, LAS float* scr, int tid) {
    { const int n = tid & 63, kb = tid >> 6;
#pragma unroll
      for (int i = 0; i < 8; ++i) scr[(kb + 8 * i) * 65 + n] = W[(size_t)(k0 + kb + 8 * i) * N + n0 + n]; }
    __syncthreads();
    { const int n = tid >> 3, kk = (tid & 7) * 8; float f[8];
#pragma unroll
      for (int j = 0; j < 8; ++j) f[j] = scr[(kk + j) * 65 + n];
      *(u32x4*)(WT + (size_t)(n0dst + n) * K + k0 + kk) = pack8(f); }
    __syncthreads();
}
DI void transpose_weight(const float* W, int K, int N, bf16* WT, LAS float* scr, int tid, int bid, int G, int& item_base, int mode) {
    const int nk = K / 64, cnt = nk * (N / 64);
    const int first = (bid - (item_base % G) + G) % G;
    for (int it = first; it < cnt; it += G) {
        const int nt = it / nk, kt = it % nk; const int n0 = nt * 64;
        int n0dst = n0;
        if (mode == 1) {
            if (n0 >= 3072 && n0 < 4608) { const int hd = (n0 - 3072) / 192, o = (n0 - 3072) % 192; n0dst = o < 128 ? 3072 + hd * 128 + o : 4096 + hd * 64 + (o - 128); }
            else if (n0 >= 5184) n0dst = n0 + 192;
        }
        transpose_tile(W, K, N, kt * 64, n0, WT, n0dst, scr, tid);
    }
    item_base += cnt;
}

DI void transpose_tile128(const float* __restrict__ W, int K, int N, int k0, int n0, bf16* WT, LAS float* scr, int tid, int mode, const float* kscale = nullptr) {
    { const int c4 = tid & 31, kr = tid >> 5; f32x4 v[4];
#pragma unroll
      for (int i = 0; i < 4; ++i) v[i] = *(const f32x4*)(W + (size_t)(k0 + kr + 16 * i) * N + n0 + 4 * c4);
      if (kscale) {
#pragma unroll
          for (int i = 0; i < 4; ++i) v[i] = v[i] * kscale[k0 + kr + 16 * i]; }
#pragma unroll
      for (int i = 0; i < 4; ++i) *(LAS f32x4*)(scr + (kr + 16 * i) * 132 + 4 * c4) = v[i]; }
    __syncthreads();
    { const int n = tid & 127, kk = (tid >> 7) * 16; float f[16];
#pragma unroll
      for (int j = 0; j < 16; ++j) f[j] = scr[(kk + j) * 132 + n];
      int nd = n0 + n;
      if (mode == 1) {
          const int nb = nd & ~63;
          if (nb >= 3072 && nb < 4608) { const int hd = (nb - 3072) / 192, o = (nb - 3072) % 192; nd = (o < 128 ? 3072 + hd * 128 + o : 4096 + hd * 64 + (o - 128)) + (nd & 63); }
          else if (nb >= 5184) nd += 192;
      }
      bf16* dst = WT + (size_t)nd * K + k0 + kk;
      *(u32x4*)dst = pack8(f); *(u32x4*)(dst + 8) = pack8(f + 8); }
    __syncthreads();
}
DI void transpose_weight128(const float* W, int K, int N, bf16* WT, LAS float* scr, int tid, int idx, int cnt, int mode = 0, int ncols = 0, const float* kscale = nullptr) {
    if (cnt <= 0) return;
    const int nk = K / 64, total = nk * ((ncols ? ncols : N) / 128);
    for (int it = idx; it < total; it += cnt) { const int nt = it / nk, kt = it % nk; transpose_tile128(W, K, N, kt * 64, nt * 128, WT, scr, tid, mode, kscale); }
}
DI void idle_share(int nwg, int& idx, int& cnt) {
    const int G = gridDim.x, rem = nwg % G, c = blockIdx.x;
    if (rem == 0) { idx = c; cnt = G; } else if (c >= rem) { idx = c - rem; cnt = G - rem; } else { idx = 0; cnt = 0; }
}
#define XB_TMO      128
#define XB_XCNT(j)  (256  + 64 * (j))
#define XB_XSUB(j)  (1280 + 64 * (j))
#define XB_XGEN(j)  (2304 + 64 * (j))
#define XB_TOP      3328
#define XB_TOPGEN   3392
#define XCD_BAR_WORDS 3456
#define XB_SPIN_CAP (1u << 18)

__device__ __forceinline__ unsigned xb_ld(unsigned* p)              { return __hip_atomic_load(p, __ATOMIC_RELAXED, __HIP_MEMORY_SCOPE_AGENT); }
__device__ __forceinline__ unsigned xb_add(unsigned* p, unsigned v) { return __hip_atomic_fetch_add(p, v, __ATOMIC_RELAXED, __HIP_MEMORY_SCOPE_AGENT); }
__device__ __forceinline__ unsigned xb_xcc_id() { return (unsigned)__builtin_amdgcn_s_getreg((3 << 11) | 20) & 0xFu; }
#define XB_SPIN(cond, bar) do { unsigned _sp = 0; while (cond) { __builtin_amdgcn_s_sleep(1); \
    if ((++_sp & 255u) == 0u) { if (xb_ld(&(bar)[XB_TMO])) break; if (_sp > XB_SPIN_CAP) { atomicAdd(&(bar)[XB_TMO], 1u); break; } } } } while (0)

struct XcdBarrier {
    unsigned* bar; unsigned x;
    volatile LAS unsigned* st;
};

__device__ __forceinline__ XcdBarrier xcd_barrier_post(unsigned* bar, volatile LAS unsigned* st) {
    XcdBarrier b; b.bar = bar; b.x = xb_xcc_id(); b.st = st;
    if (threadIdx.x == 0) (void)xb_add(&bar[XB_XCNT(b.x)], 1u);
    return b;
}
__device__ __forceinline__ void xcd_barrier_complete(unsigned* bar, unsigned x, unsigned& nloc, unsigned& nx) {
    const unsigned G = gridDim.x * gridDim.y * gridDim.z;
    unsigned sum, cnt, mine, sp = 0u;
    for (;;) {
        sum = 0u; cnt = 0u; mine = 0u;
#pragma unroll
        for (unsigned j = 0; j < 16; ++j) { const unsigned c = xb_ld(&bar[XB_XCNT(j)]); sum += c; cnt += (c > 0u) ? 1u : 0u; mine = (j == x) ? c : mine; }
        if (sum == G) break;
        __builtin_amdgcn_s_sleep(1);
        if ((++sp & 255u) == 0u) { if (xb_ld(&bar[XB_TMO])) break; if (sp > XB_SPIN_CAP) { atomicAdd(&bar[XB_TMO], 1u); break; } }
    }
    nloc = mine > 0u ? mine : 1u; nx = cnt > 0u ? cnt : 1u;
}

__device__ __forceinline__ void xcd_barrier(const XcdBarrier& b) {
    asm volatile("s_waitcnt vmcnt(0)" ::: "memory");
    __syncthreads();
    if (threadIdx.x == 0) {
        unsigned* bar = b.bar;
        __builtin_amdgcn_s_waitcnt(0);
        unsigned nloc = b.st[0], nx = b.st[1];
        if (nloc == 0u) { xcd_barrier_complete(bar, b.x, nloc, nx); b.st[0] = nloc; b.st[1] = nx; }
        const unsigned old = xb_add(&bar[XB_XSUB(b.x)], 1u);
        const unsigned gen = old / nloc;
        if (old + 1u == (gen + 1u) * nloc) {
            __builtin_amdgcn_fence(__ATOMIC_RELEASE, "agent");
            asm volatile("s_waitcnt vmcnt(0)" ::: "memory");
            const unsigned og = xb_add(&bar[XB_TOP], 1u);
            const unsigned tg = og / nx;
            if (og + 1u == (tg + 1u) * nx) xb_add(&bar[XB_TOPGEN], 1u);
            else XB_SPIN(xb_ld(&bar[XB_TOPGEN]) == tg, bar);
            __builtin_amdgcn_fence(__ATOMIC_ACQUIRE, "agent");
            xb_add(&bar[XB_XGEN(b.x)], 1u);
            asm volatile("s_waitcnt vmcnt(0)" ::: "memory");
        } else {
            XB_SPIN(xb_ld(&bar[XB_XGEN(b.x)]) == gen, bar);
            __builtin_amdgcn_fence(__ATOMIC_ACQUIRE, "agent");
            asm volatile("s_waitcnt vmcnt(0)" ::: "memory");
        }
    }
    __syncthreads();
}

DI void p0_prologue(const Args& a, LAS unsigned char* lds, int tid, int lane, int wave) {
    unsigned char* ws = a.ws;
    const int G = gridDim.x, bid = blockIdx.x;
    LAS float* scr = (LAS float*)lds;
    transpose_weight128(a.in[7], 2048, 9280, (bf16*)(ws + WS_WIN), scr, tid, bid, G, 1, 9216);
    for (int kt = bid; kt < 32; kt += G) transpose_tile(a.in[7], 2048, 9280, kt * 64, 9216, (bf16*)(ws + WS_WIN), 9216 + 192, scr, tid);
    transpose_weight128(a.in[16], 512, 2048, (bf16*)(ws + WS_WKVB), scr, tid, (bid + 64) % G, G);
    transpose_weight128(a.in[17], 1024, 2048, (bf16*)(ws + WS_WPA), scr, tid, (bid + 128) % G, G);
    transpose_weight128(a.in[18], 1024, 2048, (bf16*)(ws + WS_WPB), scr, tid, (bid + 192) % G, G);
    transpose_weight128(a.in[19], 2048, 2048, (bf16*)(ws + WS_WOUT), scr, tid, bid, G);
    if (tid < 384) { const int k = tid >> 7, e = tid & 127; float* gt = (float*)(ws + 16384);
        gt[tid] = k == 0 ? a.in[8][e] * QS_BAND : k == 1 ? a.in[9][e] : a.in[13][e] * QS_MLA; }
    { u32x4 z = {0u, 0u, 0u, 0u}; u32x4* p = (u32x4*)((bf16*)(ws + WS_WIN) + (size_t)5184 * 2048);
      for (int i = bid * 512 + tid; i < 49152; i += G * 512) p[i] = z; }
    const int gw = bid * 8 + wave, nw = G * 8;
    { const float* g = a.in[6]; bf16* XN = (bf16*)(ws + WS_XN);
      for (int row = gw; row < MT; row += nw) {
          const float* xr = row < MP ? a.in[0] + (size_t)row * 2048 : a.in[1] + (size_t)(row - MP) * 2048;
          f32x4 v[8]; float ss = 0.f;
#pragma unroll
          for (int i = 0; i < 8; ++i) { v[i] = ((const f32x4*)xr)[lane + 64 * i]; ss += v[i][0] * v[i][0] + v[i][1] * v[i][1] + v[i][2] * v[i][2] + v[i][3] * v[i][3]; }
          ss = wave_sum(ss); const float rstd = rsqrtf(ss * (1.0f / 2048.0f) + EPS);
#pragma unroll
          for (int i = 0; i < 8; ++i) { const f32x4 gv = ((const f32x4*)g)[lane + 64 * i];
              u32x2 w; w.x = pk2(v[i][0] * rstd * gv[0], v[i][1] * rstd * gv[1]); w.y = pk2(v[i][2] * rstd * gv[2], v[i][3] * rstd * gv[3]);
              *(u32x2*)(XN + (size_t)row * 2048 + 4 * (lane + 64 * i)) = w; }
      } }
}

DI void convert_caches(const Args& a, int idx, int cnt, int lane, int wave) {
    if (cnt <= 0) return;
    unsigned char* ws = a.ws; const int gw = idx * 8 + wave, nw = cnt * 8;
    { const float* cc = a.in[4]; const float* ck = a.in[5]; bf16* CKV = (bf16*)(ws + WS_CKV); bf16* KR = (bf16*)(ws + WS_KR);
      for (int r = gw; r < 8 * 2048; r += nw) {
          const int b = r >> 11, p = r & 2047; const size_t rr = (size_t)MP + (size_t)b * 2112 + p;
          const f32x4 v0 = ((const f32x4*)(cc + (size_t)r * 512))[2 * lane], v1 = ((const f32x4*)(cc + (size_t)r * 512))[2 * lane + 1];
          u32x4 w; w.x = pk2(v0[0], v0[1]); w.y = pk2(v0[2], v0[3]); w.z = pk2(v1[0], v1[1]); w.w = pk2(v1[2], v1[3]);
          *(u32x4*)(CKV + rr * 512 + 8 * lane) = w;
          KR[rr * 64 + lane] = tobf(ck[(size_t)r * 64 + lane]);
      } }
    { const float* ca = a.in[2]; const float* cv = a.in[3]; bf16* AKS = (bf16*)(ws + WS_AKS); bf16* AVS = (bf16*)(ws + WS_AVS);
      for (int r = gw; r < 8 * 512; r += nw) {
          const int b = r >> 9, p = r & 511; const size_t ro = ((size_t)b * 576 + p) * 1024 + 16 * lane;
          const f32x4* s0 = (const f32x4*)(ca + (size_t)r * 1024 + 16 * lane); const f32x4* s1 = (const f32x4*)(cv + (size_t)r * 1024 + 16 * lane);
#pragma unroll
          for (int h = 0; h < 2; ++h) {
              const f32x4 k0 = s0[2 * h], k1 = s0[2 * h + 1], v0 = s1[2 * h], v1 = s1[2 * h + 1];
              u32x4 w; w.x = pk2(k0[0], k0[1]); w.y = pk2(k0[2], k0[3]); w.z = pk2(k1[0], k1[1]); w.w = pk2(k1[2], k1[3]);
              *(u32x4*)(AKS + ro + 8 * h) = w;
              w.x = pk2(v0[0], v0[1]); w.y = pk2(v0[2], v0[3]); w.z = pk2(v1[0], v1[1]); w.w = pk2(v1[2], v1[3]);
              *(u32x4*)(AVS + ro + 8 * h) = w;
          }
      } }
}

DI void load16(const bf16* p, float* f) { unpack8(*(const u32x4*)p, f); unpack8(*(const u32x4*)(p + 8), f + 8); }
DI void store16(bf16* p, const float* f) { *(u32x4*)p = pack8(f); *(u32x4*)(p + 8) = pack8(f + 8); }
DI void storef16(float* p, const float* f) {
#pragma unroll
    for (int i = 0; i < 4; ++i) *(f32x4*)(p + 4 * i) = (f32x4){f[4 * i], f[4 * i + 1], f[4 * i + 2], f[4 * i + 3]};
}

DI void p2_norms(const Args& a, int lane, int wave) {
    unsigned char* ws = a.ws; float* out = a.out;
    bf16* BQ = (bf16*)(ws + WS_BQ); bf16* CKV = (bf16*)(ws + WS_CKV); bf16* KR = (bf16*)(ws + WS_KR);
    const float* g_kv = a.in[11]; const float* g_kr = a.in[12]; const float* g_qr = a.in[14];
    const int gw = blockIdx.x * 8 + wave, nw = gridDim.x * 8;
    const float gkr = g_kr[lane];
    const int sub = lane & 7;
    float gq8[8], fr8[8];
#pragma unroll
    for (int j = 0; j < 8; ++j) { gq8[j] = g_qr[sub * 8 + j] * QS_MLA; fr8[j] = exp2f(-(float)((sub & 3) * 8 + j) * (13.287712379549449f / 32.0f)) * 0.15915494309189535f; }
    float gkv[8];
#pragma unroll
    for (int j = 0; j < 8; ++j) gkv[j] = g_kv[lane * 8 + j];
    const float freq = exp2f(-(float)(lane & 31) * (13.287712379549449f / 32.0f));
    for (int row = gw; row < MT; row += nw) {
        const bool samp = row >= MP;
        const int s = samp ? (row - MP) & 63 : row & 4095;
        const int pos = samp ? 2048 + s : s;
        float rev = (float)pos * freq * 0.15915494309189535f; rev -= floorf(rev);
        const float cs = __builtin_amdgcn_cosf(rev), sn = __builtin_amdgcn_sinf(rev);
        const size_t rr = (size_t)rmap_row(row);
        bf16* pbr = BQ + (size_t)row * 1536 + (lane >> 3) * 192 + 128 + sub * 8; bf16* pck = CKV + rr * 512 + lane * 8; bf16* pkr = KR + rr * 64 + lane;
        float fc[8], xr[8];
        unpack8(*(const u32x4*)pbr, xr);
        unpack8(*(const u32x4*)pck, fc);
        const float xk = bf1(*pkr);
        { float ss = 0.f;
#pragma unroll
          for (int j = 0; j < 8; ++j) ss += xr[j] * xr[j];
          ss += __shfl_xor(ss, 1); ss += __shfl_xor(ss, 2); ss += __shfl_xor(ss, 4);
          const float rstd = rsqrtf(ss * (1.0f / 64.0f) + EPS);
          float o8[8];
#pragma unroll
          for (int j = 0; j < 8; ++j) { const float y = xr[j] * rstd * gq8[j], yp = __shfl_xor(y, 4);
              float rv = (float)pos * fr8[j]; rv -= floorf(rv);
              const float c = __builtin_amdgcn_cosf(rv), sn8 = __builtin_amdgcn_sinf(rv);
              o8[j] = sub < 4 ? y * c - yp * sn8 : y * c + yp * sn8; }
          *(u32x4*)pbr = pack8(o8); }
        { float ss = 0.f;
#pragma unroll
          for (int j = 0; j < 8; ++j) ss += fc[j] * fc[j];
          ss = wave_sum(ss); const float rstd = rsqrtf(ss * (1.0f / 512.0f) + EPS);
#pragma unroll
          for (int j = 0; j < 8; ++j) fc[j] = fc[j] * rstd * gkv[j];
          *(u32x4*)pck = pack8(fc);
          float* o = samp ? out + O_CKS + (size_t)(row - MP) * 512 + lane * 8 : out + O_CKP + (size_t)row * 512 + lane * 8;
          *(f32x4*)o = (f32x4){fc[0], fc[1], fc[2], fc[3]}; *(f32x4*)(o + 4) = (f32x4){fc[4], fc[5], fc[6], fc[7]}; }
        { const float x = xk;
          const float ss = wave_sum(x * x); const float y = x * rsqrtf(ss * (1.0f / 64.0f) + EPS) * gkr; const float yp = __shfl_xor(y, 32);
          const float r = lane < 32 ? y * cs - yp * sn : y * cs + yp * sn;
          *pkr = tobf(r);
          if (samp) out[O_KRS + (size_t)(row - MP) * 64 + lane] = r; else out[O_KRP + (size_t)row * 64 + lane] = r; }
    }
}

DI void p5_knnorm(const Args& a, int lane, int wave) {
    bf16* KN = (bf16*)(a.ws + WS_KN); const float* g_kn = a.in[15];
    const int gw = blockIdx.x * 8 + wave, nw = gridDim.x * 8; const int sub = lane & 7;
    float g[16];
#pragma unroll
    for (int j = 0; j < 16; ++j) g[j] = g_kn[sub * 16 + j];
    for (int row = gw; row < RALL; row += nw) {
        float f[16]; bf16* p = KN + (size_t)row * 1024 + lane * 16; load16(p, f); float ss = 0.f;
#pragma unroll
        for (int j = 0; j < 16; ++j) ss += f[j] * f[j];
        ss += __shfl_xor(ss, 1); ss += __shfl_xor(ss, 2); ss += __shfl_xor(ss, 4);
        const float rstd = rsqrtf(ss * (1.0f / 128.0f) + EPS);
#pragma unroll
        for (int j = 0; j < 16; ++j) f[j] = f[j] * rstd * g[j];
        store16(p, f);
    }
}

DI void p10_hn(const Args& a, int lane, int wave) {
    float* rs2 = (float*)(a.ws + 32768); bf16* H16 = (bf16*)(a.ws + WS_H16);
    const int gw = blockIdx.x * 8 + wave, nw = gridDim.x * 8;
    for (int row = gw; row < MT; row += nw) {
        float ss = 0.f;
        if (row < MP) {
            const u32x4* hr = (const u32x4*)(H16 + (size_t)row * 2048);
            float t[4][8];
#pragma unroll
            for (int q = 0; q < 4; ++q) unpack8(hr[lane + 64 * q], t[q]);
#pragma unroll
            for (int q = 0; q < 4; ++q)
#pragma unroll
                for (int e = 0; e < 8; ++e) ss += t[q][e] * t[q][e];
        } else {
            f32x4 v[8];
            const float* xr = a.in[1] + (size_t)(row - MP) * 2048; const float* pr = (const float*)(a.ws + WS_PART1) + (size_t)(row - MP) * 2048;
#pragma unroll
            for (int i = 0; i < 8; ++i) { v[i] = ((const f32x4*)xr)[lane + 64 * i];
#pragma unroll
                for (int k = 0; k < 8; ++k) v[i] += ((const f32x4*)(pr + (size_t)k * (MS * 2048)))[lane + 64 * i];
                ((f32x4*)(a.out + (size_t)row * 2048))[lane + 64 * i] = v[i];
                u32x2 w; w.x = pk2(v[i][0], v[i][1]); w.y = pk2(v[i][2], v[i][3]);
                *(u32x2*)(H16 + (size_t)row * 2048 + 4 * (lane + 64 * i)) = w;
                const float b0 = bflo(w.x), b1 = bfhi(w.x), b2 = bflo(w.y), b3 = bfhi(w.y);
                ss += b0 * b0 + b1 * b1 + b2 * b2 + b3 * b3; }
        }
        ss = wave_sum(ss);
        if (lane == 0) rs2[row] = 1.0f / (ss * (1.0f / 2048.0f) + EPS);
    }
}

constexpr int AT_BUF = 40960, AT_V = 16384, AT_KR = 32768, AT_TAB = 122880;
#define MFMA32(a, b, c) __builtin_amdgcn_mfma_f32_32x32x16_bf16((a), (b), (c), 0, 0, 0)
#define GLDS16(gsrc, ldst) __builtin_amdgcn_global_load_lds((const unsigned*)(gsrc), (LAS unsigned*)(ldst), 16, 0, 0)
DI s16x4 vtr(const LAS unsigned char* p) { return __builtin_bit_cast(s16x4, __builtin_amdgcn_ds_read_tr16_b64_v4i16((LAS v4i16_t*)p)); }

struct AttnOffs { unsigned k[2], v[2], kr; };
template <bool MLA>
DI AttnOffs attn_offs(int kstride, int vstride, int wave, int lane) {
    AttnOffs o;
#pragma unroll
    for (int i = 0; i < 2; ++i) {
        const int p = 2 * wave + i;
        { const int row = 4 * p + (lane >> 4), c = (lane & 15) ^ (row & 15); o.k[i] = (unsigned)(row * kstride + c * 8) * 2u; }
        { const int sub = 2 * p + (lane >> 5), kb = sub >> 2, db = sub & 3, key = 8 * kb + ((lane & 31) >> 2), d = 32 * db + 8 * (lane & 3); o.v[i] = (unsigned)(key * vstride + d) * 2u; }
    }
    { const int row = 8 * wave + (lane >> 3), c = (lane & 7) ^ ((row >> 1) & 7); o.kr = (unsigned)(row * 64 + c * 8) * 2u; }
    return o;
}
template <bool MLA>
DI void attn_load_tile(LAS unsigned char* buf, const bf16* Kp, int kstride, const bf16* KRp, const bf16* Vp, int vstride, int t, int wave, const AttnOffs& o) {
    const char* kt = (const char*)(Kp + (size_t)t * 64 * kstride); const char* vt = (const char*)(Vp + (size_t)t * 64 * vstride);
#pragma unroll
    for (int i = 0; i < 2; ++i) {
        GLDS16(kt + o.k[i], buf + (2 * wave + i) * 1024);
        GLDS16(vt + o.v[i], buf + AT_V + (2 * wave + i) * 1024);
    }
    if (MLA) { const char* rt = (const char*)(KRp + (size_t)t * 64 * 64); GLDS16(rt + o.kr, buf + AT_KR + wave * 1024); }
}
#define AT_SYNC() asm volatile("s_waitcnt vmcnt(0) lgkmcnt(0)\n\ts_barrier" ::: "memory")

template <bool MLA>
DI void attn_unit(LAS unsigned char* lds, const bf16* Qp, int qstride, const bf16* Kp, int kstride, const bf16* KRp, const bf16* Vp, int vstride,
                  bf16* Op, int ostride, int t_lo, int t_hi, int qc, bool active, int wave, int lane) {
    constexpr int NKS = MLA ? 12 : 8;
    const int r = lane & 31, h = lane >> 5;
    bf16x8 qf[NKS];
    if (active) {
#pragma unroll
        for (int ks = 0; ks < NKS; ++ks) qf[ks] = *(const bf16x8*)(Qp + (size_t)(32 * wave + r) * qstride + 16 * ks + 8 * h);
    } else {
#pragma unroll
        for (int ks = 0; ks < NKS; ++ks) qf[ks] = (bf16x8){0, 0, 0, 0, 0, 0, 0, 0};
    }
    f32x16 o[4];
#pragma unroll
    for (int d = 0; d < 4; ++d)
#pragma unroll
        for (int i = 0; i < 16; ++i) o[d][i] = 0.f;
    float m_run = -1e30f, l_run = 0.f;
    const int kxor = h ^ (r & 15);
    const int koff = r * 256;
    const int krx = h ^ ((r >> 1) & 7);
    const int kroff = r * 128;
    const int voff = (4 * h + ((lane & 15) >> 2)) * 64 + ((lane >> 4) & 1) * 32 + (lane & 3) * 8;
    const LAS float* tab = (const LAS float*)(lds + AT_TAB);

    const AttnOffs offs = attn_offs<MLA>(kstride, vstride, wave, lane);
    constexpr int NP = MLA ? 5 : 4;
#define AT_BAR() asm volatile("s_waitcnt lgkmcnt(0)\n\ts_barrier" ::: "memory")
#define AT_WAITBAR(pre) do { if (pre) asm volatile("s_waitcnt vmcnt(%0) lgkmcnt(0)\n\ts_barrier" :: "i"(NP) : "memory"); else asm volatile("s_waitcnt vmcnt(0) lgkmcnt(0)\n\ts_barrier" ::: "memory"); } while (0)
    const int grp = wave >> 2, nt = t_hi - t_lo + 1;
    attn_load_tile<MLA>(lds, Kp, kstride, KRp, Vp, vstride, t_lo, wave, offs);
    if (nt > 1) attn_load_tile<MLA>(lds + AT_BUF, Kp, kstride, KRp, Vp, vstride, t_lo + 1, wave, offs);
    AT_SYNC();
    if (grp) AT_BAR();
    f32x16 s0, s1;
#pragma unroll
    for (int i = 0; i < 16; ++i) { s0[i] = 0.f; s1[i] = 0.f; }
    int bi = 0;
    for (int t = t_lo; t <= t_hi; ++t) {
        LAS unsigned char* buf = lds + bi * AT_BUF;
        LAS unsigned char* nbuf = lds + (bi == 0 ? 2 : bi - 1) * AT_BUF;
        bi = bi == 2 ? 0 : bi + 1;
        const bool pre = t + 2 <= t_hi;
        const bool doit = active && t <= qc && (MLA || t >= qc - 8);
        if (doit) {
#pragma unroll
            for (int i = 0; i < 16; ++i) { s0[i] = 0.f; s1[i] = 0.f; }
            {
                int kx = kxor, kr_ = krx; asm volatile("" : "+v"(kx), "+v"(kr_));
#define AT_KLD(ks, kt) ((ks) < 8 ? *(const LAS bf16x8*)(buf + (kt) * 8192 + koff + (((2 * (ks)) ^ kx) << 4)) \
                                 : *(const LAS bf16x8*)(buf + AT_KR + (kt) * 4096 + kroff + (((2 * ((ks) - 8)) ^ kr_) << 4)))
                bf16x8 ka[3][2];
                ka[0][0] = AT_KLD(0, 0); ka[0][1] = AT_KLD(0, 1); ka[1][0] = AT_KLD(1, 0); ka[1][1] = AT_KLD(1, 1);
#pragma unroll
                for (int ks = 0; ks < NKS; ++ks) {
                    if (ks + 2 < NKS) { ka[(ks + 2) % 3][0] = AT_KLD(ks + 2, 0); ka[(ks + 2) % 3][1] = AT_KLD(ks + 2, 1); }
                    __builtin_amdgcn_sched_barrier(0);
                    s0 = MFMA32(ka[ks % 3][0], qf[ks], s0); s1 = MFMA32(ka[ks % 3][1], qf[ks], s1);
                    __builtin_amdgcn_sched_barrier(0);
                }
#undef AT_KLD
            }
            if (!MLA) {
                const int delta = qc - t;
                if (delta >= 5) { const float c = tab[319];
#pragma unroll
                    for (int i = 0; i < 16; ++i) { s0[i] += c; s1[i] += c; }
                } else {
                    const int dbase = 64 * delta + (wave & 1) * 32 + r - 4 * h + 63;
#pragma unroll
                    for (int i = 0; i < 16; ++i) {
                        const int kk = (i & 3) + 8 * (i >> 2);
                        int i0 = dbase - kk; i0 = i0 > 319 ? 319 : i0;
                        int i1 = dbase - kk - 32; i1 = i1 > 319 ? 319 : i1;
                        s0[i] += tab[i0]; s1[i] += tab[i1];
                    }
                }
            }
        }
        if (grp) AT_WAITBAR(false); else AT_BAR();
        if (pre) attn_load_tile<MLA>(nbuf, Kp, kstride, KRp, Vp, vstride, t + 2, wave, offs);
        if (doit) {
            float mx = s0[0];
#pragma unroll
            for (int i = 1; i < 16; ++i) mx = fmaxf(mx, s0[i]);
#pragma unroll
            for (int i = 0; i < 16; ++i) mx = fmaxf(mx, s1[i]);
            mx = fmaxf(mx, __shfl_xor(mx, 32));
            const float m_new = fmaxf(m_run, mx);
            const float alpha = __builtin_amdgcn_exp2f(m_run - m_new);
            m_run = m_new;
            float ps = 0.f;
#pragma unroll
            for (int i = 0; i < 16; ++i) { s0[i] = __builtin_amdgcn_exp2f(s0[i] - m_new); s1[i] = __builtin_amdgcn_exp2f(s1[i] - m_new); ps += s0[i] + s1[i]; }
            l_run = l_run * alpha + ps;
#pragma unroll
            for (int d = 0; d < 4; ++d)
#pragma unroll
                for (int i = 0; i < 16; ++i) o[d][i] *= alpha;
#pragma unroll
            for (int kt = 0; kt < 2; ++kt) {
#pragma unroll
                for (int s = 0; s < 2; ++s) {
                    u32x4 pw;
                    if (kt == 0) { pw.x = pk2(s0[8 * s], s0[8 * s + 1]); pw.y = pk2(s0[8 * s + 2], s0[8 * s + 3]); pw.z = pk2(s0[8 * s + 4], s0[8 * s + 5]); pw.w = pk2(s0[8 * s + 6], s0[8 * s + 7]); }
                    else { pw.x = pk2(s1[8 * s], s1[8 * s + 1]); pw.y = pk2(s1[8 * s + 2], s1[8 * s + 3]); pw.z = pk2(s1[8 * s + 4], s1[8 * s + 5]); pw.w = pk2(s1[8 * s + 6], s1[8 * s + 7]); }
                    const bf16x8 pb = __builtin_bit_cast(bf16x8, pw);
#pragma unroll
                    for (int dt = 0; dt < 4; ++dt) {
                        const s16x4 lo = vtr(buf + AT_V + ((4 * kt + 2 * s) * 4 + dt) * 512 + voff);
                        const s16x4 hi = vtr(buf + AT_V + ((4 * kt + 2 * s + 1) * 4 + dt) * 512 + voff);
                        const bf16x8 va = __builtin_shufflevector(lo, hi, 0, 1, 2, 3, 4, 5, 6, 7);
                        o[dt] = MFMA32(va, pb, o[dt]);
                    }
                    __builtin_amdgcn_sched_barrier(0);
                }
            }
        }
        if (!grp) AT_WAITBAR(pre); else AT_BAR();
    }
    if (!grp) AT_BAR();
#undef AT_BAR
#undef AT_WAITBAR
    if (active) {
        const float lt = l_run + __shfl_xor(l_run, 32);
        const float inv = 1.0f / lt;
        int lane2 = lane; asm volatile("" : "+v"(lane2));
        bf16* orow = Op + (size_t)(32 * wave + (lane2 & 31)) * ostride + 4 * (lane2 >> 5);
#pragma unroll
        for (int dt = 0; dt < 4; ++dt)
#pragma unroll
            for (int g = 0; g < 4; ++g) {
                u32x2 w; w.x = pk2(o[dt][4 * g] * inv, o[dt][4 * g + 1] * inv); w.y = pk2(o[dt][4 * g + 2] * inv, o[dt][4 * g + 3] * inv);
                *(u32x2*)(orow + 32 * dt + 8 * g) = w;
            }
    }
}

DI void p3_band(const Args& a, LAS unsigned char* lds, int tid, int lane, int wave, int nrep) {
    unsigned char* ws = a.ws;
    bf16* AQ = (bf16*)(ws + WS_AQ); const bf16* AK = (const bf16*)(ws + WS_AK); const bf16* AV = (const bf16*)(ws + WS_AV);
    const bf16* AKS = (const bf16*)(ws + WS_AKS); const bf16* AVS = (const bf16*)(ws + WS_AVS);
    const float* rel = a.in[10];
    LAS float* tab = (LAS float*)(lds + AT_TAB);
#pragma unroll 1
    for (int rp = 0; rp < nrep; ++rp)
    for (int idx0 = blockIdx.x; idx0 < 576; idx0 += gridDim.x) {
        int idx = idx0;
        if (gridDim.x == 256 && idx0 < 512) { const int x = idx0 & 7, local = (idx0 >> 8) * 32 + ((idx0 >> 3) & 31); idx = ((4 * x + (local >> 4)) << 4) | (local & 15); }
        int b, hd, u = 0; const bool samp = idx >= 512;
        if (!samp) { u = idx & 15; hd = (idx >> 4) & 7; b = idx >> 7; } else { const int j = idx - 512; hd = j & 7; b = j >> 3; }
        if (tid < 320) tab[tid] = rel[hd * 320 + tid] * LOG2E;
        if (!samp) {
            const size_t rb = (size_t)b * 4096;
            bf16* Qp = AQ + (rb + 256 * u) * 1024 + hd * 128;
            const int t_lo = 4 * u - 8 > 0 ? 4 * u - 8 : 0;
            attn_unit<false>(lds, Qp, 1024, AK + rb * 1024 + hd * 128, 1024, nullptr, AV + rb * 1024 + hd * 128, 1024, Qp, 1024,
                             t_lo, 4 * u + 3, 4 * u + (wave >> 1), true, wave, lane);
        } else {
            bf16* Qp = AQ + ((size_t)MP + 64 * b) * 1024 + hd * 128;
            attn_unit<false>(lds, Qp, 1024, AKS + (size_t)b * 576 * 1024 + hd * 128, 1024, nullptr, AVS + (size_t)b * 576 * 1024 + hd * 128, 1024, Qp, 1024,
                             0, 8, 8, wave < 2, wave, lane);
        }
    }
}

DI void p6_mla(const Args& a, LAS unsigned char* lds, int lane, int wave, int nrep) {
    unsigned char* ws = a.ws;
    const bf16* BQ = (const bf16*)(ws + WS_BQ); const bf16* KN = (const bf16*)(ws + WS_KN); const bf16* KR = (const bf16*)(ws + WS_KR);
    const bf16* VB = (const bf16*)(ws + WS_VB); bf16* OB = (bf16*)(ws + WS_OB);
#pragma unroll 1
    for (int rp = 0; rp < nrep; ++rp) {
    for (int it0 = blockIdx.x; it0 < 256; it0 += gridDim.x) {
        const int it = (gridDim.x == 256) ? (((it0 & 7) * 4 + (it0 >> 6)) * 8 + ((it0 >> 3) & 7)) : it0;
        const int bh = it >> 3, slot = it & 7, b = bh >> 3, hd = bh & 7;
        const size_t rb = (size_t)b * 4096;
#pragma unroll 1
        for (int half = 0; half < 2; ++half) {
            const int u = slot < 7 ? (half ? 2 + slot : 15 - slot) : half;
            attn_unit<true>(lds, BQ + (rb + 256 * u) * 1536 + hd * 192, 1536, KN + rb * 1024 + hd * 128, 1024, KR + rb * 64, VB + rb * 1024 + hd * 128, 1024,
                            OB + (rb + 256 * u) * 1024 + hd * 128, 1024, 0, 4 * u + 3, 4 * u + (wave >> 1), true, wave, lane);
        }
        if (slot == 7) {
#pragma unroll 1
            for (int k = 0; k < 2; ++k) {
                const int j = 2 * bh + k, sb = j >> 3, shd = j & 7;
                const size_t kb = (size_t)MP + (size_t)sb * 2112;
                attn_unit<true>(lds, BQ + ((size_t)MP + 64 * sb) * 1536 + shd * 192, 1536, KN + kb * 1024 + shd * 128, 1024, KR + kb * 64, VB + kb * 1024 + shd * 128, 1024,
                                OB + ((size_t)MP + 64 * sb) * 1024 + shd * 128, 1024, 0, 32, 32, wave < 2, wave, lane);
            }
        }
    }
    }
}

#ifndef PROBE_REP
#define PROBE_REP 0
#endif
#ifndef SKEW_STEPS
#define SKEW_STEPS 0
#endif
template <class Epi>
DI void run_gemm(LAS unsigned char* lds, const bf16* A, const bf16* Bt, int M, int N, int K, const Epi& E) {
    for (int i = 0, n = SKEW_STEPS * (((int)blockIdx.x >> 3) & 3); i < n; ++i) __builtin_amdgcn_s_sleep(127);
    pg8::Gemm g{A, Bt, M, N, K, K, K}; pg8::StaticOrder S; S.init(M, N, (int)gridDim.x, (int)blockIdx.x);
    pg8::gemm_phase<Epi, pg8::StaticOrder, true, true>(lds, g, S, E);
}
template <class Epi>
DI void run_gemm_splitk(LAS unsigned char* lds, const bf16* A, const bf16* Bt, int M, int N, int Kfull, int nsplit, const Epi& E) {
    pg8::Gemm g{A, Bt, M, N, Kfull / nsplit, Kfull, Kfull}; pg8::SplitOrder S; S.init(M, N, nsplit, (int)gridDim.x, (int)blockIdx.x);
    pg8::gemm_phase<Epi, pg8::SplitOrder, true, true>(lds, g, S, E);
}

__global__ void __launch_bounds__(512, 2) mega_fwd(Args a) {
    extern __shared__ __attribute__((aligned(16))) unsigned char lds_raw[];
    LAS unsigned char* lds = (LAS unsigned char*)lds_raw;
    cg::grid_group grid = cg::this_grid();
    const int tid = threadIdx.x, lane = tid & 63, wave = __builtin_amdgcn_readfirstlane(tid >> 6);
    unsigned char* ws = a.ws;
    { volatile LAS unsigned* st0 = (volatile LAS unsigned*)(lds + 131072 + 2048); if (tid == 0) { st0[0] = 0u; st0[1] = 0u; } }
    __syncthreads();
    const XcdBarrier xbar = xcd_barrier_post((unsigned*)ws, (volatile LAS unsigned*)(lds + 131072 + 2048));
    const int lo = a.ph_lo, hi = a.ph_hi;
#define IN(k) (lo <= (k) && (k) < hi)
#define GRID_BAR() xcd_barrier(xbar)
#define SEAM(k) do { if ((k) == 0) grid.sync(); else GRID_BAR(); } while (0)

#define REPEAT(k) _Pragma("unroll") for (int it_ = 0; it_ < (1 + ((PROBE_REP >> (k)) & 1)); ++it_) if (it_ > 0 && ({ GRID_BAR(); false; })) {} else
    if (IN(0)) REPEAT(0) p0_prologue(a, lds, tid, lane, wave);
    SEAM(0);
    if (IN(1)) REPEAT(1) { EpiInProj E{(bf16*)(ws + WS_AQ), (bf16*)(ws + WS_BQ), (bf16*)(ws + WS_CKV), (bf16*)(ws + WS_KR), (bf16*)(ws + WS_GA), (bf16*)(ws + WS_AKS), (bf16*)(ws + WS_AVS), a.out, (const float*)(ws + 16384), (LAS float*)(lds + 131072 + 4096)};
        run_gemm(lds, (const bf16*)(ws + WS_XN), (const bf16*)(ws + WS_WIN), MT, NIN, 2048, E);
        if (it_ == 0) { int idx, cnt; idle_share((MT / 256) * (NIN / 256), idx, cnt); convert_caches(a, idx, cnt, lane, wave); } }
    SEAM(1);
    if (IN(2)) p2_norms(a, lane, wave);
    SEAM(2);
    if (IN(3)) { p3_band(a, lds, tid, lane, wave, 1 + ((PROBE_REP >> 3) & 1));
        EpiExpand E{(bf16*)(ws + WS_KN) + (size_t)32768 * 1024, (bf16*)(ws + WS_VTMP), a.in[15], (LAS float*)(lds + 131072 + 4096)};
        const int G = gridDim.x; const int cs = G >= 128 ? ((int)blockIdx.x - 64 + G) % G : (int)blockIdx.x;
        pg8::Gemm g{(const bf16*)(ws + WS_CKV) + (size_t)32768 * 512, (const bf16*)(ws + WS_WKVB), 512, 2048, 512, 512, 512}; pg8::SplitOrder S; S.init(512, 2048, 1, G, cs);
        pg8::gemm_phase<EpiExpand, pg8::SplitOrder, true, true>(lds, g, S, E); }
    SEAM(3);
    if (IN(4)) { { const u32x4* src = (const u32x4*)(ws + WS_VTMP); u32x4* dst = (u32x4*)((bf16*)(ws + WS_VB) + (size_t)32768 * 1024);
          for (int i = (int)blockIdx.x * 512 + tid; i < 65536; i += (int)gridDim.x * 512) dst[i] = src[i]; }
        EpiExpand E{(bf16*)(ws + WS_KN), (bf16*)(ws + WS_VB), a.in[15], (LAS float*)(lds + 131072 + 4096)};
        run_gemm(lds, (const bf16*)(ws + WS_CKV), (const bf16*)(ws + WS_WKVB), 32768, 2048, 512, E); }
    SEAM(4);
    if (IN(6)) p6_mla(a, lds, lane, wave, 1 + ((PROBE_REP >> 6) & 1));
    SEAM(6);
    if (IN(7)) REPEAT(7) { EpiMerge E{(const unsigned char*)(ws + WS_GA), (bf16*)(ws + WS_MIX), 0};
        run_gemm(lds, (const bf16*)(ws + WS_OA), (const bf16*)(ws + WS_WPA), MT, 2048, 1024, E);
        if (it_ == 0) { int idx, cnt; idle_share((MT / 256) * 8, idx, cnt); transpose_weight128(a.in[21], 2048, 8192, (bf16*)(ws + WS_WUP), (LAS float*)lds, tid, idx, cnt, 0, 0, a.in[20]); } }
    if (IN(8)) { EpiMerge E{(const unsigned char*)(ws + WS_GB), (bf16*)(ws + WS_MIX), 1};
        run_gemm(lds, (const bf16*)(ws + WS_OB), (const bf16*)(ws + WS_WPB), MT, 2048, 1024, E);
        { int idx, cnt; idle_share((MT / 256) * 8, idx, cnt); transpose_weight128(a.in[22], 8192, 2048, (bf16*)(ws + WS_WDN), (LAS float*)lds, tid, idx, cnt); } }
    SEAM(8);
    if (IN(9)) REPEAT(9) { EpiH16 E{a.in[0], (bf16*)(ws + WS_H16)};
        run_gemm(lds, (const bf16*)(ws + WS_MIX), (const bf16*)(ws + WS_WOUT), MP, 2048, 2048, E);
        EpiPartial E2{(float*)(ws + WS_PART1)};
        run_gemm_splitk(lds, (const bf16*)(ws + WS_MIX) + (size_t)MP * 2048, (const bf16*)(ws + WS_WOUT), MS, 2048, 2048, 8, E2); }
    SEAM(9);
    if (IN(10)) REPEAT(10) p10_hn(a, lane, wave);
    SEAM(10);
    if (IN(11)) REPEAT(11) { EpiUp E{(bf16*)(ws + WS_U)};
        run_gemm(lds, (const bf16*)(ws + WS_H16), (const bf16*)(ws + WS_WUP), MT, DFF, 2048, E); }
    SEAM(11);
    if (IN(12)) { EpiY E{(const bf16*)(ws + WS_H16), a.out, (const float*)(ws + 32768)};
        run_gemm(lds, (const bf16*)(ws + WS_U), (const bf16*)(ws + WS_WDN), MP, 2048, DFF, E);
        EpiPartial E2{(float*)(ws + WS_PART2)};
        run_gemm_splitk(lds, (const bf16*)(ws + WS_U) + (size_t)MP * DFF, (const bf16*)(ws + WS_WDN), MS, 2048, DFF, 16, E2); }
    SEAM(12);
    if (IN(13)) {
        const int gw = blockIdx.x * 8 + wave, nw = gridDim.x * 8;
        for (int r = gw; r < MS * 8; r += nw) {
            const int row = r >> 3, cg_ = r & 7; const size_t o = (size_t)row * 2048 + cg_ * 256 + lane * 4;
            f32x4 v = *(const f32x4*)(a.out + (size_t)MP * 2048 + o); const float* pr = (const float*)(ws + WS_PART2) + o;
            f32x4 d = *(const f32x4*)pr;
#pragma unroll
            for (int k = 1; k < 16; ++k) d += *(const f32x4*)(pr + (size_t)k * (MS * 2048));
            *(f32x4*)(a.out + (size_t)MP * 2048 + o) = v + d * ((const float*)(ws + 32768))[MP + row];
        }
    }
#undef REPEAT
#undef IN
#undef SEAM
}

extern "C" void kernel_launch(void* const* d_in, const int* in_sizes, int n_in, void* d_out, int out_size, void* d_ws, size_t ws_size, hipStream_t stream) {
    static int grid = 0;
    if (grid == 0) {
        int dev = 0, cus = 0, per_cu = 0;
        (void)hipGetDevice(&dev);
        (void)hipDeviceGetAttribute(&cus, hipDeviceAttributeMultiprocessorCount, dev);
        if (hipFuncSetAttribute((const void*)mega_fwd, hipFuncAttributeMaxDynamicSharedMemorySize, LDS_BYTES) != hipSuccess) fprintf(stderr, "kernel_launch: hipFuncSetAttribute failed\n");
        if (hipOccupancyMaxActiveBlocksPerMultiprocessor(&per_cu, (const void*)mega_fwd, 512, LDS_BYTES) != hipSuccess || per_cu < 1) { fprintf(stderr, "kernel_launch: occupancy query gave %d\n", per_cu); per_cu = 1; }
        (void)hipGetLastError();
        if (per_cu > 1) per_cu = 1;
        grid = cus * per_cu;
        if (ws_size < WS_END) fprintf(stderr, "kernel_launch: workspace too small: %zu < %zu\n", ws_size, (size_t)WS_END);
        if (n_in != 23) fprintf(stderr, "kernel_launch: expected 23 inputs, got %d\n", n_in);
    }
    Args a{};
    for (int i = 0; i < 23; ++i) a.in[i] = (const float*)d_in[i];
    a.out = (float*)d_out; a.ws = (unsigned char*)d_ws; a.ph_lo = 0; a.ph_hi = 14; a.rep = 0; a.pad = 0;
    (void)hipMemsetAsync(d_ws, 0, 16384, stream);
    void* args[] = {&a};
    hipError_t e = hipLaunchCooperativeKernel((const void*)mega_fwd, dim3(grid), dim3(512), args, LDS_BYTES, stream);
    if (e != hipSuccess) fprintf(stderr, "kernel_launch: cooperative launch failed: %s (grid %d)\n", hipGetErrorString(e), grid);
}
```
